# Optimizing an MI355X kernel written in HIP

```python
import math
import jax, jax.numpy as jnp
from jax import lax
import numpy as np


D_MODEL = 1024
BATCH = 4
SEQ = 8192
DEPTH = 1

HEAD_DIM = 64
ROPE_DIM = HEAD_DIM // 4
ROPE_THETA = 500000.0
Q_BLOCK = 128
A_HEADS = 8
A_KV_RANK = 256
A_TOPK_MAX = 256
IDX_HEADS = 8
IDX_DIM = 32
IDX_ROPE = IDX_DIM // 4
B_PATTERNS = ((128, 1), (512, 4), (2048, 16))
B_HEADS_PER_GROUP = 4
B_HEADS = B_HEADS_PER_GROUP * len(B_PATTERNS)
N_EXPERTS = 64
TOP_K = 8
N_GROUPS = 8
TOPK_GROUPS = 4
D_EXPERT = 256
D_SHARED = 256
ROUTED_SCALE = 2.5
MOE_BLOCK = 128
ALPHA = (2.0 * DEPTH) ** 0.25
BETA = (8.0 * DEPTH) ** -0.25
LN_EPS = 1e-5
RMS_EPS = 1e-6
IN_SIZES = (A_HEADS * HEAD_DIM, A_KV_RANK, ROPE_DIM, IDX_HEADS * IDX_DIM, IDX_DIM, IDX_HEADS,
            B_HEADS * HEAD_DIM, B_HEADS * HEAD_DIM, B_HEADS * HEAD_DIM, D_MODEL, D_MODEL)
IN_TOTAL = sum(IN_SIZES)
V_COL_BLOCK = 8

kernel_name = 'hybrid_dsa_dilated_moe_deepnorm'


def layer_norm(x, g, b):
    xf = x.astype(jnp.float32)
    mu = jnp.mean(xf, -1, keepdims=True)
    var = jnp.mean(jnp.square(xf - mu), -1, keepdims=True)
    y = (xf - mu) * lax.rsqrt(var + LN_EPS) * g.astype(jnp.float32) + b.astype(jnp.float32)
    return y.astype(x.dtype)


def rms_norm(x, g):
    xf = x.astype(jnp.float32)
    y = xf * lax.rsqrt(jnp.mean(jnp.square(xf), -1, keepdims=True) + RMS_EPS) * g.astype(jnp.float32)
    return y.astype(x.dtype)


def rope(x, pos):
    dim = x.shape[-1]
    inv = ROPE_THETA ** (-jnp.arange(0, dim, 2, dtype=jnp.float32) / dim)
    ang = pos.astype(jnp.float32)[:, :, None] * inv
    cos = jnp.cos(ang)[:, :, None, :]
    sin = jnp.sin(ang)[:, :, None, :]
    xf = x.astype(jnp.float32)
    x1, x2 = xf[..., :dim // 2], xf[..., dim // 2:]
    return jnp.concatenate([x1 * cos - x2 * sin, x2 * cos + x1 * sin], -1).astype(x.dtype)


def partial_rope(x, pos, rot):
    return jnp.concatenate([rope(x[..., :rot], pos), x[..., rot:]], -1)


def to_blocks(x):
    b, s = x.shape[:2]
    return jnp.moveaxis(x.reshape(b, s // Q_BLOCK, Q_BLOCK, *x.shape[2:]), 1, 0)


def from_blocks(x):
    y = jnp.moveaxis(x, 0, 1)
    return y.reshape(y.shape[0], y.shape[1] * y.shape[2], *y.shape[3:])


def dsa_mixer(q_a, ckv, k_rope, iq, ik, iw, w_uk, w_uv):
    s_len = q_a.shape[1]
    n_sel = min(A_TOPK_MAX, s_len // 4)
    scale = HEAD_DIM ** -0.5
    key_pos = jnp.arange(s_len)

    def block(args):
        qb, iqb, iwb, start = args
        tq = start + jnp.arange(Q_BLOCK)
        causal = key_pos[None, :] <= tq[:, None]
        s = jnp.einsum('bthd,bsd->bths', iqb, ik)
        score = jnp.einsum('bths,bth->bts', jax.nn.relu(s), iwb).astype(jnp.float32)
        score = jnp.where(causal[None], score, -jnp.inf)
        _, idx = lax.top_k(score, n_sel)
        valid = idx <= tq[None, :, None]
        c_sel = jax.vmap(lambda c, i: c[i])(ckv, idx)
        r_sel = jax.vmap(lambda r, i: r[i])(k_rope, idx)
        q_lat = jnp.einsum('bthd,rhd->bthr', qb[..., ROPE_DIM:], w_uk)
        logits = (jnp.einsum('bthr,btkr->bthk', q_lat, c_sel)
                  + jnp.einsum('bthd,btkd->bthk', qb[..., :ROPE_DIM], r_sel)).astype(jnp.float32) * scale
        logits = jnp.where(valid[:, :, None, :], logits, -jnp.inf)
        p = jax.nn.softmax(logits, axis=-1).astype(c_sel.dtype)
        o_lat = jnp.einsum('bthk,btkr->bthr', p, c_sel)
        return jnp.einsum('bthr,rhd->bthd', o_lat, w_uv)

    starts = jnp.arange(s_len // Q_BLOCK, dtype=jnp.int32) * Q_BLOCK
    out = lax.map(block, (to_blocks(q_a), to_blocks(iq), to_blocks(iw), starts))
    return from_blocks(out)


def dilated_mixer(qb, kb, vb):
    s_len = qb.shape[1]
    scale = HEAD_DIM ** -0.5
    groups = []
    for g, (win, dil) in enumerate(B_PATTERNS):
        hs = slice(g * B_HEADS_PER_GROUP, (g + 1) * B_HEADS_PER_GROUP)
        groups.append((hs, win, dil, kb[:, :, hs], vb[:, :, hs]))

    def block(args):
        q, start = args
        tq = start + jnp.arange(Q_BLOCK)
        outs, lses = [], []
        for hs, win, dil, kg, vg in groups:
            n_keys = win // dil + 1
            kpos = tq[:, None] - dil * jnp.arange(n_keys)[None, :]
            valid = kpos >= 0
            kpos = jnp.maximum(kpos, 0)
            ksel = jnp.take(kg, kpos, axis=1)
            vsel = jnp.take(vg, kpos, axis=1)
            l = jnp.einsum('bthd,btjhd->bthj', q[:, :, hs], ksel).astype(jnp.float32) * scale
            l = jnp.where(valid[None, :, None, :], l, -jnp.inf)
            m = jnp.max(l, -1, keepdims=True)
            e = jnp.exp(l - m)
            den = jnp.sum(e, -1)
            o = jnp.einsum('bthj,btjhd->bthd', e, vsel.astype(jnp.float32)) / den[..., None]
            outs.append(o)
            lses.append(m[..., 0] + jnp.log(den))
        wts = jax.nn.softmax(jnp.stack(lses), axis=0)
        return jnp.sum(wts[..., None] * jnp.stack(outs), axis=0).astype(q.dtype)

    starts = jnp.arange(s_len // Q_BLOCK, dtype=jnp.int32) * Q_BLOCK
    return from_blocks(lax.map(block, (to_blocks(qb), starts)))


def routed_experts(hf, top_idx, top_w, w1_e, w3_e, w2_e):
    n_tok, d = hf.shape
    n_asg = n_tok * TOP_K
    flat_e = top_idx.reshape(-1).astype(jnp.int32)
    flat_t = jnp.repeat(jnp.arange(n_tok, dtype=jnp.int32), TOP_K)
    flat_w = top_w.reshape(-1)
    order = jnp.argsort(flat_e)
    se, st, sw = flat_e[order], flat_t[order], flat_w[order]
    counts = jnp.bincount(flat_e, length=N_EXPERTS)
    padded = (counts + MOE_BLOCK - 1) // MOE_BLOCK * MOE_BLOCK
    start = jnp.cumsum(counts) - counts
    pend = jnp.cumsum(padded)
    pstart = pend - padded
    dest = pstart[se] + (jnp.arange(n_asg) - start[se])
    n_rows = n_asg + N_EXPERTS * MOE_BLOCK
    n_blk = n_rows // MOE_BLOCK
    row_t = jnp.full((n_rows,), n_tok, jnp.int32).at[dest].set(st)
    row_w = jnp.zeros((n_rows,), hf.dtype).at[dest].set(sw.astype(hf.dtype))
    blk_e = jnp.minimum(jnp.searchsorted(pend, jnp.arange(n_blk) * MOE_BLOCK, side='right'), N_EXPERTS - 1)
    x_pad = jnp.concatenate([hf, jnp.zeros((1, d), hf.dtype)], 0)

    def step(acc, inp):
        t, w, e = inp
        xb = x_pad[t]
        hb = jax.nn.silu(xb @ w1_e[e]) * (xb @ w3_e[e])
        return acc.at[t].add((hb @ w2_e[e]) * w[:, None]), None

    acc, _ = lax.scan(step, jnp.zeros((n_tok + 1, d), hf.dtype),
                      (row_t.reshape(n_blk, MOE_BLOCK), row_w.reshape(n_blk, MOE_BLOCK), blk_e))
    return acc[:n_tok]


def moe(h, w_router, router_bias, w1_e, w3_e, w2_e, ws1, ws3, ws2):
    b, s, d = h.shape
    hf = h.reshape(-1, d)
    n_tok = hf.shape[0]
    scores = jax.nn.sigmoid((hf @ w_router).astype(jnp.float32))
    biased = scores + router_bias.astype(jnp.float32)
    grp = biased.reshape(n_tok, N_GROUPS, N_EXPERTS // N_GROUPS)
    grp_score = jnp.sum(lax.top_k(grp, 2)[0], -1)
    _, gidx = lax.top_k(grp_score, TOPK_GROUPS)
    gmask = jnp.any(gidx[..., None] == jnp.arange(N_GROUPS), axis=1)
    emask = jnp.repeat(gmask, N_EXPERTS // N_GROUPS, axis=1)
    _, top_idx = lax.top_k(jnp.where(emask, biased, -jnp.inf), TOP_K)
    top_s = jnp.take_along_axis(scores, top_idx, axis=1)
    top_w = top_s / jnp.sum(top_s, -1, keepdims=True) * ROUTED_SCALE
    routed = routed_experts(hf, top_idx, top_w, w1_e, w3_e, w2_e)
    shared = (jax.nn.silu(hf @ ws1) * (hf @ ws3)) @ ws2
    return (routed + shared).reshape(b, s, d)


def hybrid_layer(x, positions, w_in, b_gate, g_kv, w_uk, w_uv, w_branch_a, w_branch_b, w_o,
                 ln1_g, ln1_b, w_router, router_bias, w1_e, w3_e, w2_e, ws1, ws3, ws2, ln2_g, ln2_b):
    b, s, d = x.shape
    proj = x @ w_in
    splits = np.cumsum(IN_SIZES)[:-1].tolist()
    aq, ckv, akr, iq, ik, iw, bq, bk, bv, ga, gb = jnp.split(proj, splits, axis=-1)
    g_a = jax.nn.sigmoid(ga + b_gate[:d])
    g_b = jax.nn.sigmoid(gb + b_gate[d:])
    aq = partial_rope(aq.reshape(b, s, A_HEADS, HEAD_DIM), positions, ROPE_DIM)
    ckv = rms_norm(ckv, g_kv)
    akr = rope(akr[:, :, None, :], positions)[:, :, 0]
    iq = partial_rope(iq.reshape(b, s, IDX_HEADS, IDX_DIM), positions, IDX_ROPE)
    ik = partial_rope(ik[:, :, None, :], positions, IDX_ROPE)[:, :, 0]
    iw = iw * (IDX_HEADS * IDX_DIM) ** -0.5
    a_out = dsa_mixer(aq, ckv, akr, iq, ik, iw, w_uk, w_uv).reshape(b, s, A_HEADS * HEAD_DIM)
    bq = partial_rope(bq.reshape(b, s, B_HEADS, HEAD_DIM), positions, ROPE_DIM)
    bk = partial_rope(bk.reshape(b, s, B_HEADS, HEAD_DIM), positions, ROPE_DIM)
    bv = bv.reshape(b, s, B_HEADS, HEAD_DIM)
    b_out = dilated_mixer(bq, bk, bv).reshape(b, s, B_HEADS_PER_GROUP * HEAD_DIM)
    mix = (g_a * (a_out @ w_branch_a) + g_b * (b_out @ w_branch_b)) @ w_o
    h = layer_norm(ALPHA * x + mix, ln1_g, ln1_b)
    ffn = moe(h, w_router, router_bias, w1_e, w3_e, w2_e, ws1, ws3, ws2)
    return layer_norm(ALPHA * h + ffn, ln2_g, ln2_b)


def setup_inputs(seed: int = 0) -> dict:
    key = jax.random.key(seed)
    ks = jax.random.split(key, 24)
    f32 = jnp.float32
    L, D = DEPTH, D_MODEL

    def nrm(k, shape, scale):
        return jax.random.normal(k, shape, f32) * scale

    x = jax.random.normal(ks[0], (BATCH, SEQ, D), f32)
    offset = jax.random.randint(ks[1], (BATCH, 1), 0, 4096, dtype=jnp.int32)
    positions = offset + jnp.arange(SEQ, dtype=jnp.int32)[None, :]
    col_scale = jnp.concatenate([jnp.full((n,), BETA if i == V_COL_BLOCK else 1.0, f32)
                                 for i, n in enumerate(IN_SIZES)])
    w_in = nrm(ks[2], (L, D, IN_TOTAL), D ** -0.5) * col_scale
    b_gate = nrm(ks[3], (L, 2 * D), 0.02)
    g_kv = 1.0 + nrm(ks[4], (L, A_KV_RANK), 0.02)
    w_uk = nrm(ks[5], (L, A_KV_RANK, A_HEADS, HEAD_DIM - ROPE_DIM), A_KV_RANK ** -0.5)
    w_uv = nrm(ks[6], (L, A_KV_RANK, A_HEADS, HEAD_DIM), BETA * A_KV_RANK ** -0.5)
    w_branch_a = nrm(ks[7], (L, A_HEADS * HEAD_DIM, D), BETA * (A_HEADS * HEAD_DIM) ** -0.5)
    w_branch_b = nrm(ks[8], (L, B_HEADS_PER_GROUP * HEAD_DIM, D), BETA * (B_HEADS_PER_GROUP * HEAD_DIM) ** -0.5)
    w_o = nrm(ks[9], (L, D, D), BETA * D ** -0.5)
    ln1_g = 1.0 + nrm(ks[10], (L, D), 0.02)
    ln1_b = nrm(ks[11], (L, D), 0.02)
    w_router = nrm(ks[12], (L, D, N_EXPERTS), D ** -0.5)
    router_bias = nrm(ks[13], (L, N_EXPERTS), 0.01)
    w1_e = nrm(ks[14], (L, N_EXPERTS, D, D_EXPERT), BETA * D ** -0.5)
    w3_e = nrm(ks[15], (L, N_EXPERTS, D, D_EXPERT), BETA * D ** -0.5)
    w2_e = nrm(ks[16], (L, N_EXPERTS, D_EXPERT, D), BETA * D_EXPERT ** -0.5)
    ws1 = nrm(ks[17], (L, D, D_SHARED), BETA * D ** -0.5)
    ws3 = nrm(ks[18], (L, D, D_SHARED), BETA * D ** -0.5)
    ws2 = nrm(ks[19], (L, D_SHARED, D), BETA * D_SHARED ** -0.5)
    ln2_g = 1.0 + nrm(ks[20], (L, D), 0.02)
    ln2_b = nrm(ks[21], (L, D), 0.02)
    return {'x': x, 'positions': positions, 'w_in': w_in, 'b_gate': b_gate, 'g_kv': g_kv,
            'w_uk': w_uk, 'w_uv': w_uv, 'w_branch_a': w_branch_a, 'w_branch_b': w_branch_b,
            'w_o': w_o, 'ln1_g': ln1_g, 'ln1_b': ln1_b, 'w_router': w_router,
            'router_bias': router_bias, 'w1_e': w1_e, 'w3_e': w3_e, 'w2_e': w2_e,
            'ws1': ws1, 'ws3': ws3, 'ws2': ws2, 'ln2_g': ln2_g, 'ln2_b': ln2_b}


def reference(x, positions, w_in, b_gate, g_kv, w_uk, w_uv, w_branch_a, w_branch_b, w_o,
              ln1_g, ln1_b, w_router, router_bias, w1_e, w3_e, w2_e, ws1, ws3, ws2, ln2_g, ln2_b):
    h = x
    for l in range(DEPTH):
        h = hybrid_layer(h, positions, w_in[l], b_gate[l], g_kv[l], w_uk[l], w_uv[l],
                         w_branch_a[l], w_branch_b[l], w_o[l], ln1_g[l], ln1_b[l],
                         w_router[l], router_bias[l], w1_e[l], w3_e[l], w2_e[l],
                         ws1[l], ws3[l], ws2[l], ln2_g[l], ln2_b[l])
    return h
```

```cpp
#include <hip/hip_runtime.h>
#include <cstdio>
#include <cstdint>

#define LAS __attribute__((address_space(3)))
#define GAS __attribute__((address_space(1)))
typedef unsigned short bf16;
typedef short bf16x8 __attribute__((ext_vector_type(8)));
typedef short bf16x4 __attribute__((ext_vector_type(4)));
typedef float f32x4 __attribute__((ext_vector_type(4)));
typedef float f32x2 __attribute__((ext_vector_type(2)));
typedef unsigned u32x4 __attribute__((ext_vector_type(4)));
typedef unsigned u32x2 __attribute__((ext_vector_type(2)));
typedef GAS unsigned gu32;

constexpr int NTOK = 32768, DM = 1024, SEQ = 8192, NBATCH = 4;
constexpr int NIN = 5432, NINP = 5632;
constexpr int NEXP = 64, DEXP = 256;
constexpr float ALPHA = 1.189207115002721f;
constexpr float LN_EPS = 1e-5f, RMS_EPS = 1e-6f;
constexpr int KVS = 288;
constexpr int IN_AQ = 0, IN_CKV = 512, IN_AKR = 768, IN_IQ = 784, IN_IK = 1040, IN_IW = 1072, IN_BQ = 1080, IN_BK = 1848, IN_BV = 2616, IN_GA = 3384, IN_GB = 4408;

constexpr size_t MiB = 1u << 20;
constexpr size_t WS_CTL = 0, CTL_ZERO_BYTES = 512 * 1024;
constexpr size_t WS_R16 = 1 * MiB, WS_R8 = 3 * MiB;
constexpr size_t WS_WA = 4 * MiB, WS_WQ = 5 * MiB, WS_WV = 6 * MiB, WS_WO = 8 * MiB, WS_WB = 10 * MiB, WS_REC = 11 * MiB;
constexpr size_t WS_QL = 12 * MiB, WS_KV = 140 * MiB, WS_IQ = 158 * MiB, WS_AQ = 174 * MiB, WS_IK = 206 * MiB, WS_IW = 208 * MiB;
constexpr size_t WS_BQ = 210 * MiB, WS_BK = 258 * MiB, WS_BV = 306 * MiB, WS_BO = 354 * MiB;
constexpr size_t WS_WIN = 370 * MiB, WS_XB = 381 * MiB, WS_OL = 370 * MiB;
constexpr size_t WS_AO = 12 * MiB, WS_T1 = 44 * MiB, WS_MP = 108 * MiB;
constexpr size_t WS_HBF = 140 * MiB, WS_W13 = 204 * MiB, WS_LIST = 302 * MiB, WS_WLIST = 310 * MiB, WS_HB = 318 * MiB, WS_W2 = 471 * MiB, WS_Y = 12 * MiB;
constexpr size_t WS_WAB = 498 * MiB;
constexpr size_t WS_END = 504 * MiB;
constexpr int CW_BAR = 4096;
constexpr int CW_W2Q = 8768;
constexpr int CW_BQ = 8192;
constexpr int CW_CNT = 16384;

constexpr int LDS_BYTES = 163840;
constexpr int LDS_BARW = LDS_BYTES - 64;
constexpr int NWAVES = 8;

typedef __bf16 bf16v2_t __attribute__((ext_vector_type(2)));
__device__ __forceinline__ unsigned cvt_pk_bf16(float lo, float hi) { const bf16v2_t r = __builtin_convertvector((f32x2){lo, hi}, bf16v2_t); return __builtin_bit_cast(unsigned, r); }
__device__ __forceinline__ float bf2f(unsigned b) { return __uint_as_float(b << 16); }
__device__ __forceinline__ float wave_sum(float v) {
#pragma unroll
    for (int o = 1; o < 64; o <<= 1) v += __shfl_xor(v, o);
    return v;
}
#define LDS_WAIT() asm volatile("s_waitcnt lgkmcnt(0)" ::: "memory")
#define VM_WAIT() asm volatile("s_waitcnt vmcnt(0)" ::: "memory")

#define XB_TMO      128
#define XB_XCNT(j)  (256  + 64 * (j))
#define XB_XSUB(j)  (1280 + 64 * (j))
#define XB_XGEN(j)  (2304 + 64 * (j))
#define XB_TOP      3328
#define XB_TOPGEN   3392
#define XCD_BAR_WORDS 3456
#define XB_SPIN_CAP (1u << 18)
__device__ __forceinline__ unsigned xb_ld(unsigned* p)              { return __hip_atomic_load(p, __ATOMIC_RELAXED, __HIP_MEMORY_SCOPE_AGENT); }
__device__ __forceinline__ unsigned xb_add(unsigned* p, unsigned v) { return __hip_atomic_fetch_add(p, v, __ATOMIC_RELAXED, __HIP_MEMORY_SCOPE_AGENT); }
__device__ __forceinline__ unsigned xb_xcc_id() { return (unsigned)__builtin_amdgcn_s_getreg((3 << 11) | 20) & 0xFu; }
#define XB_SPIN(cond, bar) do { unsigned _sp = 0; while (cond) { __builtin_amdgcn_s_sleep(1); \
    if ((++_sp & 255u) == 0u) { if (xb_ld(&(bar)[XB_TMO])) break; if (_sp > XB_SPIN_CAP) { atomicAdd(&(bar)[XB_TMO], 1u); break; } } } } while (0)
struct XcdBarrier { unsigned* bar; unsigned x; volatile LAS unsigned* st; };
__device__ __forceinline__ XcdBarrier xcd_barrier_post(unsigned* bar, volatile LAS unsigned* st) {
    XcdBarrier b; b.bar = bar; b.x = xb_xcc_id(); b.st = st;
    if (threadIdx.x == 0) (void)xb_add(&bar[XB_XCNT(b.x)], 1u);
    return b;
}
__device__ __forceinline__ void xcd_barrier_complete(unsigned* bar, unsigned x, unsigned& nloc, unsigned& nx) {
    const unsigned G = gridDim.x * gridDim.y * gridDim.z;
    unsigned sum, cnt, mine, sp = 0u;
    for (;;) {
        sum = 0u; cnt = 0u; mine = 0u;
#pragma unroll
        for (unsigned j = 0; j < 16; ++j) { const unsigned c = xb_ld(&bar[XB_XCNT(j)]); sum += c; cnt += (c > 0u) ? 1u : 0u; mine = (j == x) ? c : mine; }
        if (sum == G) break;
        __builtin_amdgcn_s_sleep(1);
        if ((++sp & 255u) == 0u) { if (xb_ld(&bar[XB_TMO])) break; if (sp > XB_SPIN_CAP) { atomicAdd(&bar[XB_TMO], 1u); break; } }
    }
    nloc = mine > 0u ? mine : 1u; nx = cnt > 0u ? cnt : 1u;
}
__device__ __forceinline__ void xcd_barrier(const XcdBarrier& b) {
    asm volatile("s_waitcnt vmcnt(0)" ::: "memory");
    __syncthreads();
    if (threadIdx.x == 0) {
        unsigned* bar = b.bar;
        __builtin_amdgcn_s_waitcnt(0);
        unsigned nloc = b.st[0], nx = b.st[1];
        if (nloc == 0u) { xcd_barrier_complete(bar, b.x, nloc, nx); b.st[0] = nloc; b.st[1] = nx; }
        const unsigned old = xb_add(&bar[XB_XSUB(b.x)], 1u);
        const unsigned gen = old / nloc;
        if (old + 1u == (gen + 1u) * nloc) {
            __builtin_amdgcn_fence(__ATOMIC_RELEASE, "agent");
            asm volatile("s_waitcnt vmcnt(0)" ::: "memory");
            const unsigned og = xb_add(&bar[XB_TOP], 1u);
            const unsigned tg = og / nx;
            if (og + 1u == (tg + 1u) * nx) xb_add(&bar[XB_TOPGEN], 1u);
            else XB_SPIN(xb_ld(&bar[XB_TOPGEN]) == tg, bar);
            __builtin_amdgcn_fence(__ATOMIC_ACQUIRE, "agent");
            xb_add(&bar[XB_XGEN(b.x)], 1u);
            asm volatile("s_waitcnt vmcnt(0)" ::: "memory");
        } else {
            XB_SPIN(xb_ld(&bar[XB_XGEN(b.x)]) == gen, bar);
            __builtin_amdgcn_fence(__ATOMIC_ACQUIRE, "agent");
            asm volatile("s_waitcnt vmcnt(0)" ::: "memory");
        }
    }
    __syncthreads();
}

namespace gp {
constexpr int BM = 256, BK = 64, HALF = 128, HTB = HALF * BK * 2, STAGE_BYTES = 8 * HTB, NXCD = 8, WGM = 8;
__host__ __device__ __forceinline__ int lds_byte(int r, int c) { const int st = (r >> 4) * 2 + (c >> 5), rr = r & 15, cc = c & 31, ob = rr * 64 + cc * 2; return st * 1024 + (ob ^ (((ob >> 9) & 1) << 5)); }
__host__ __device__ __forceinline__ int perm32(int rho) { const int n = rho >> 4, i = rho & 15; return 8 * (i >> 2) + 4 * n + (i & 3); }
__host__ __device__ __forceinline__ void stage_rc(int b, int& R, int& C) { const int st = b / 1024, sb = b % 1024, swz = sb ^ (((sb >> 9) & 1) << 5); R = (st >> 1) * 16 + swz / 64; C = (st & 1) * 32 + (swz % 64) / 2; }

struct U { const char* A; const char* B; const int* rows; int rbase; int nvalid; int r0; int c0; int x0; int x1; };

struct DenseOrder {
    const char* A; const char* B; int lda, ldb; int nM, nN, nwg, G, c;
    __device__ void init(const void* A_, const void* B_, int lda_, int ldb_, int M, int N, int G_, int c_) { A = (const char*)A_; B = (const char*)B_; lda = lda_; ldb = ldb_; nM = M / BM; nN = N / BM; nwg = nM * nN; G = G_; c = c_; }
    __device__ __forceinline__ bool next(int i, U& u) const {
        const long L = (long)i * G + c; if (L >= nwg) return false;
        int wgid = (int)L; { const int q = nwg / NXCD, r = nwg % NXCD, xcd = wgid % NXCD, off = wgid / NXCD; wgid = (xcd < r ? xcd * (q + 1) : r * (q + 1) + (xcd - r) * q) + off; }
        const int nig = WGM * nN, gid = wgid / nig, fm = gid * WGM, gsz = (nM - fm) < WGM ? (nM - fm) : WGM;
        const int pm = fm + ((wgid % nig) % gsz), pn = (wgid % nig) / gsz;
        u.A = A + (size_t)pm * BM * lda; u.B = B + (size_t)pn * BM * ldb; u.rows = nullptr; u.rbase = 0; u.nvalid = 256; u.r0 = pm * BM; u.c0 = pn; u.x0 = 0; u.x1 = 0;
        return true;
    }
};

template <class Epi, class Sched, bool GATHER>
__device__ __forceinline__ void gemm_phase(LAS unsigned char* lds, const int K, const int lda, const int ldb, const Sched& S, const Epi& E) {
    const int tid = threadIdx.x, wid = __builtin_amdgcn_readfirstlane(tid >> 6), lane = tid & 63, wr = wid >> 2, wc = wid & 3, fr = lane & 15, fq = lane >> 4;
    const int nt = K / BK;
    int R0, C0, R1, C1; stage_rc(tid * 16, R0, C0); stage_rc(tid * 16 + 8192, R1, C1);
    const int Rb0 = Epi::PERM ? ((R0 & ~31) + perm32(R0 & 31)) : R0, Rb1 = Epi::PERM ? ((R1 & ~31) + perm32(R1 & 31)) : R1;
    const unsigned voffB0 = (unsigned)(Rb0 * ldb + C0 * 2), voffB1 = (unsigned)(Rb1 * ldb + C1 * 2);
    const size_t kstep = (size_t)(BK * 2);
    const size_t hstepB = (size_t)HALF * ldb;
    const unsigned ldsw = (unsigned)wid * 1024u;
    const int aoff = lds_byte(wr * 64 + fr, fq * 8), boff = lds_byte(wc * 32 + fr, fq * 8);
#define GP_SA(b, h) (((b) * 2 + (h)) * HTB)
#define GP_SB(b, h) ((4 + (b) * 2 + (h)) * HTB)
#define GP_STAGE2(bufoff, gptr, v0, v1) do { \
        __builtin_amdgcn_global_load_lds((const unsigned*)((const char*)(gptr) + (v0)), (LAS unsigned*)(lds + (bufoff) + ldsw), 16, 0, 0); \
        __builtin_amdgcn_global_load_lds((const unsigned*)((const char*)(gptr) + (v1)), (LAS unsigned*)(lds + (bufoff) + ldsw + 8192), 16, 0, 0); } while (0)
#define GP_STB(bufoff, gptr) GP_STAGE2(bufoff, gptr, voffB0, voffB1)
#define GP_LDA(dst, b, h) do { _Pragma("unroll") for (int m = 0; m < 4; ++m) _Pragma("unroll") for (int k = 0; k < 2; ++k) dst[m][k] = *(const LAS bf16x8*)(lds + GP_SA(b, h) + aoff + m * 2048 + k * 1024); } while (0)
#define GP_LDB(dst, b, h) do { _Pragma("unroll") for (int n = 0; n < 2; ++n) _Pragma("unroll") for (int k = 0; k < 2; ++k) dst[n][k] = *(const LAS bf16x8*)(lds + GP_SB(b, h) + boff + n * 2048 + k * 1024); } while (0)
#define GP_MMA(ai, bj, At, Bt) do { __builtin_amdgcn_s_setprio(1); _Pragma("unroll") for (int m = 0; m < 4; ++m) _Pragma("unroll") for (int n = 0; n < 2; ++n) _Pragma("unroll") for (int k = 0; k < 2; ++k) \
        acc[ai][bj][m][n] = __builtin_amdgcn_mfma_f32_16x16x32_bf16(Bt[n][k], At[m][k], acc[ai][bj][m][n], 0, 0, 0); __builtin_amdgcn_s_setprio(0); } while (0)
#define GP_WAIT_V(n) asm volatile("s_waitcnt vmcnt(" #n ")" ::: "memory")
#define GP_WAIT_L(n) asm volatile("s_waitcnt lgkmcnt(" #n ")" ::: "memory")
#define GP_BAR __builtin_amdgcn_s_barrier()
#define GP_SCHED __builtin_amdgcn_sched_barrier(0)
#define GP_AOFF(u, v00, v01, v10, v11) do { \
        if (GATHER) { int t00, t01, t10, t11; \
            if ((u).rows) { t00 = R0 < (u).nvalid ? (u).rows[R0] : 0; t01 = R1 < (u).nvalid ? (u).rows[R1] : 0; t10 = R0 + HALF < (u).nvalid ? (u).rows[R0 + HALF] : 0; t11 = R1 + HALF < (u).nvalid ? (u).rows[R1 + HALF] : 0; } \
            else { t00 = (u).rbase + R0; t01 = (u).rbase + R1; t10 = (u).rbase + R0 + HALF; t11 = (u).rbase + R1 + HALF; } \
            v00 = (unsigned)(t00 * lda + C0 * 2); v01 = (unsigned)(t01 * lda + C1 * 2); v10 = (unsigned)(t10 * lda + C0 * 2); v11 = (unsigned)(t11 * lda + C1 * 2); } \
        else { v00 = (unsigned)(R0 * lda + C0 * 2); v01 = (unsigned)(R1 * lda + C1 * 2); v10 = (unsigned)((R0 + HALF) * lda + C0 * 2); v11 = (unsigned)((R1 + HALF) * lda + C1 * 2); } } while (0)
    U cur, nxt; int ui = 0;
    if (!S.next(0, cur)) return;
    f32x4 acc[2][2][4][2];
#pragma unroll
    for (int a = 0; a < 2; ++a)
#pragma unroll
        for (int b = 0; b < 2; ++b)
#pragma unroll
            for (int m = 0; m < 4; ++m)
#pragma unroll
                for (int n = 0; n < 2; ++n) acc[a][b][m][n] = (f32x4){0.f, 0.f, 0.f, 0.f};
    bf16x8 At[4][2], B0[2][2], B1[2][2];
    unsigned c00, c01, c10, c11, n00, n01, n10, n11;
    GP_AOFF(cur, c00, c01, c10, c11);
    n00 = c00; n01 = c01; n10 = c10; n11 = c11;
    const char* cA = cur.A; const char* cB = cur.B;
    GP_STB(GP_SB(0, 0), cB); GP_STB(GP_SB(0, 1), cB + hstepB); GP_STAGE2(GP_SA(0, 0), cA, c00, c01); GP_STAGE2(GP_SA(0, 1), cA, c10, c11);
    if (wr == 1) GP_BAR;
    GP_WAIT_V(2); GP_BAR;
    GP_STB(GP_SB(1, 0), cB + kstep); GP_STAGE2(GP_SA(1, 0), cA + kstep, c00, c01); GP_STB(GP_SB(1, 1), cB + hstepB + kstep);
    GP_WAIT_V(6); GP_BAR;
    for (;;) {
        const bool has_next = S.next(ui + 1, nxt);
        const char* nA = has_next ? nxt.A : cA; const char* nB = has_next ? nxt.B : cB;
        if (GATHER) { if (has_next) GP_AOFF(nxt, n00, n01, n10, n11); else { n00 = c00; n01 = c01; n10 = c10; n11 = c11; } }
#pragma nounroll
        for (int t = 0; t < nt; t += 2) {
            if constexpr (Epi::MID_T > 0) { if (t == Epi::MID_T) E.mid(acc, cur, wr, wc, fr, fq); }
            const bool last = (t == nt - 2);
            const char* a1 = cA + (size_t)(t + 1) * kstep;
            const char* a2 = last ? nA : cA + (size_t)(t + 2) * kstep; const char* b2 = last ? nB : cB + (size_t)(t + 2) * kstep;
            const char* a3 = a2 + kstep; const char* b3 = b2 + kstep;
            unsigned s00 = c00, s01 = c01, s10 = c10, s11 = c11;
            if (GATHER) { s00 = last ? n00 : c00; s01 = last ? n01 : c01; s10 = last ? n10 : c10; s11 = last ? n11 : c11; }
            GP_LDB(B0, 0, 0); GP_LDB(B1, 0, 1); GP_SCHED; GP_LDA(At, 0, 0); GP_STAGE2(GP_SA(1, 1), a1, c10, c11);
            GP_WAIT_V(8); GP_WAIT_L(0); GP_BAR; GP_MMA(0, 0, At, B0); GP_MMA(0, 1, At, B1); GP_BAR; GP_SCHED;
            GP_LDA(At, 0, 1); GP_STB(GP_SB(0, 0), b2); GP_STB(GP_SB(0, 1), b2 + hstepB); GP_STAGE2(GP_SA(0, 0), a2, s00, s01);
            GP_WAIT_V(8); GP_WAIT_L(0); GP_BAR; GP_MMA(1, 0, At, B0); GP_MMA(1, 1, At, B1); GP_BAR; GP_SCHED;
            GP_LDB(B0, 1, 0); GP_LDB(B1, 1, 1); GP_SCHED; GP_LDA(At, 1, 0); GP_STAGE2(GP_SA(0, 1), a2, s10, s11);
            GP_WAIT_V(8); GP_WAIT_L(0); GP_BAR; GP_MMA(0, 0, At, B0); GP_MMA(0, 1, At, B1); GP_BAR; GP_SCHED;
            GP_LDA(At, 1, 1); GP_STB(GP_SB(1, 0), b3); GP_STB(GP_SB(1, 1), b3 + hstepB); GP_STAGE2(GP_SA(1, 0), a3, s00, s01);
            GP_WAIT_V(8); GP_WAIT_L(0); GP_BAR; GP_MMA(1, 0, At, B0); GP_MMA(1, 1, At, B1); GP_BAR; GP_SCHED;
        }
        if (wr == 0) GP_BAR;
        E(acc, cur, wr, wc, fr, fq);
        if (!has_next) break;
#pragma unroll
        for (int a = 0; a < 2; ++a)
#pragma unroll
            for (int b = 0; b < 2; ++b)
#pragma unroll
                for (int m = 0; m < 4; ++m)
#pragma unroll
                    for (int n = 0; n < 2; ++n) acc[a][b][m][n] = (f32x4){0.f, 0.f, 0.f, 0.f};
        cur = nxt; cA = nA; cB = nB; ++ui;
        c00 = n00; c01 = n01; c10 = n10; c11 = n11;
        if (wr == 1) GP_BAR;
    }
    GP_WAIT_V(0);
    GP_BAR;
#undef GP_SA
#undef GP_SB
#undef GP_STAGE2
#undef GP_STB
#undef GP_LDA
#undef GP_LDB
#undef GP_MMA
#undef GP_WAIT_V
#undef GP_WAIT_L
#undef GP_BAR
#undef GP_SCHED
#undef GP_AOFF
}
}

struct Args { const void* in[22]; float* out; unsigned char* ws; int ph_lo, ph_hi; };

struct Ptrs {
    const float *x, *w_in, *b_gate, *g_kv, *w_uk, *w_uv, *w_ba, *w_bb, *w_o, *ln1_g, *ln1_b, *w_router, *router_bias, *w1_e, *w3_e, *w2_e, *ws1, *ws3, *ws2, *ln2_g, *ln2_b;
    const int* positions;
    float* out; unsigned char* ws; gu32* ctl;
    bf16 *XB, *WIN, *WQ, *WV, *WO, *QL, *KV, *IQ, *AQ, *IK, *BQ, *BK, *BV, *OL, *AB, *WAB, *MP, *HBF, *W13, *W2, *HB, *Y;
    unsigned char* G;
    float *IW; f32x2 *R16, *R8; unsigned* REC; int* LIST; float* WLIST;
};

constexpr float YSCALE = 16.f;
__device__ __forceinline__ unsigned pk4_fp8(float a, float b, float c, float d) { unsigned w = 0u; w = __builtin_amdgcn_cvt_pk_fp8_f32(a, b, w, false); w = __builtin_amdgcn_cvt_pk_fp8_f32(c, d, w, true); return w; }
__device__ __forceinline__ f32x4 up4_fp8(unsigned w) { const f32x2 lo = __builtin_amdgcn_cvt_pk_f32_fp8((int)w, false), hi = __builtin_amdgcn_cvt_pk_f32_fp8((int)w, true); return (f32x4){lo.x, lo.y, hi.x, hi.y}; }
__device__ __forceinline__ void st4(bf16* p, f32x4 v) { u32x2 w; w.x = cvt_pk_bf16(v.x, v.y); w.y = cvt_pk_bf16(v.z, v.w); *(u32x2*)p = w; }
__device__ __forceinline__ void st8(bf16* p, f32x4 a, f32x4 b) { u32x4 w; w.x = cvt_pk_bf16(a.x, a.y); w.y = cvt_pk_bf16(a.z, a.w); w.z = cvt_pk_bf16(b.x, b.y); w.w = cvt_pk_bf16(b.z, b.w); *(u32x4*)p = w; }
__device__ __forceinline__ void st8nt(bf16* p, f32x4 a, f32x4 b) { u32x4 w; w.x = cvt_pk_bf16(a.x, a.y); w.y = cvt_pk_bf16(a.z, a.w); w.z = cvt_pk_bf16(b.x, b.y); w.w = cvt_pk_bf16(b.z, b.w); __builtin_nontemporal_store(w, (u32x4*)p); }
__device__ __forceinline__ void ld8bf(const bf16* p, f32x4& a, f32x4& b) { const u32x4 w = *(const u32x4*)p; a = (f32x4){__uint_as_float(w.x << 16), __uint_as_float(w.x & 0xffff0000u), __uint_as_float(w.y << 16), __uint_as_float(w.y & 0xffff0000u)}; b = (f32x4){__uint_as_float(w.z << 16), __uint_as_float(w.z & 0xffff0000u), __uint_as_float(w.w << 16), __uint_as_float(w.w & 0xffff0000u)}; }
__device__ __forceinline__ f32x4 ld4bf(const bf16* p) { const u32x2 w = *(const u32x2*)p; return (f32x4){__uint_as_float(w.x << 16), __uint_as_float(w.x & 0xffff0000u), __uint_as_float(w.y << 16), __uint_as_float(w.y & 0xffff0000u)}; }
__device__ __forceinline__ f32x4 rope4(f32x4 v, f32x4 cs) { return (f32x4){v.x * cs.x - v.y * cs.y, v.y * cs.x + v.x * cs.y, v.z * cs.z - v.w * cs.w, v.w * cs.z + v.z * cs.w}; }

__device__ __forceinline__ void tr_item(const float* W, int ldw, int k0, int sc, float scale, bf16* WT, size_t ldd, int n0, LAS float* scr, int lane) {
#pragma unroll 8
    for (int i = 0; i < 32; ++i) { const int kk = 2 * i + (lane >> 5); scr[kk * 33 + (lane & 31)] = sc >= 0 ? W[(size_t)(k0 + kk) * ldw + sc] * scale : 0.f; }
    LDS_WAIT(); asm volatile("" ::: "memory");
    const int c = lane & 7;
#pragma unroll
    for (int j = 0; j < 4; ++j) { const int n = (lane >> 3) + 8 * j; const LAS float* s = scr + (8 * c) * 33 + n;
        u32x4 o; o.x = cvt_pk_bf16(s[0 * 33], s[1 * 33]); o.y = cvt_pk_bf16(s[2 * 33], s[3 * 33]); o.z = cvt_pk_bf16(s[4 * 33], s[5 * 33]); o.w = cvt_pk_bf16(s[6 * 33], s[7 * 33]);
        *(u32x4*)(WT + (size_t)(n0 + n) * ldd + k0 + 8 * c) = o; }
    LDS_WAIT(); asm volatile("" ::: "memory");
}
__device__ __forceinline__ void tr_load(const float* W, int ldw, int k0, int sc, float (&v)[32], int lane) {
#pragma unroll
    for (int i = 0; i < 32; ++i) v[i] = sc >= 0 ? W[(size_t)(k0 + 2 * i + (lane >> 5)) * ldw + sc] : 0.f;
}
__device__ __forceinline__ void tr_finish(const float (&v)[32], float scale, bf16* WT, size_t ldd, int n0, int k0, int lane) {
    unsigned w[32];
#pragma unroll
    for (int i = 0; i < 32; ++i) { const auto r = __builtin_amdgcn_permlane32_swap(__float_as_uint(v[i]), __float_as_uint(v[i]), false, false);
        w[i] = cvt_pk_bf16(__uint_as_float(r[0]) * scale, __uint_as_float(r[1]) * scale); }
    const bool up = lane >= 32; bf16* dst = WT + (size_t)(n0 + (lane & 31)) * ldd + k0 + (up ? 32 : 0);
#pragma unroll
    for (int j = 0; j < 4; ++j) { u32x4 o; o.x = up ? w[16 + 4 * j] : w[4 * j]; o.y = up ? w[17 + 4 * j] : w[4 * j + 1]; o.z = up ? w[18 + 4 * j] : w[4 * j + 2]; o.w = up ? w[19 + 4 * j] : w[4 * j + 3];
        *(u32x4*)(dst + 8 * j) = o; }
}
__device__ __forceinline__ void win_src(int n, int& sc, float& scale) {
    const int pn = n >> 8, c = n & 255; scale = 1.f; sc = -1;
    if (pn < 2) { const int cc = pn * 256 + c, hh = cc >> 6, dd = cc & 63; const int o = dd < 16 ? (dd >> 1) + 8 * (dd & 1) : dd; sc = IN_AQ + hh * 64 + o; scale = 0.125f; }
    else if (pn == 2) sc = IN_CKV + c;
    else if (pn == 3) { const int hh = c >> 5, dd = c & 31; const int o = dd < 8 ? (dd >> 1) + 4 * (dd & 1) : dd; sc = IN_IQ + hh * 32 + o; }
    else if (pn == 4) {
        if (c < 16) sc = IN_AKR + (c >> 1) + 8 * (c & 1);
        else if (c < 48) { const int dd = c - 16; sc = IN_IK + (dd < 8 ? (dd >> 1) + 4 * (dd & 1) : dd); }
        else if (c < 56) { sc = IN_IW + (c - 48); scale = 0.0625f; }
    }
    else if (pn < 11) { const int isk = pn >= 8; const int cc = (pn - (isk ? 8 : 5)) * 256 + c, hh = cc >> 6, dd = cc & 63; const int o = dd < 16 ? (dd >> 1) + 8 * (dd & 1) : dd; sc = (isk ? IN_BK : IN_BQ) + hh * 64 + o; scale = isk ? 1.f : 0.125f; }
    else if (pn < 14) sc = IN_BV + (pn - 11) * 256 + c;
    else { const int co = 64 * ((c >> 5) & 3) + 16 * ((c >> 3) & 3) + 8 * (c >> 7) + (c & 7);
        sc = (pn < 18 ? IN_GA + (pn - 14) * 256 : IN_GB + (pn - 18) * 256) + co; }
}
__device__ __forceinline__ void p0_phase(const Ptrs& P, LAS unsigned char* lds, int gw, int NGW, int wave, int lane) {
    LAS float* scr = (LAS float*)(lds + wave * 16384);
    float cw[32]; int csc = -1; float cscale = 1.f; const bool chas = gw < 176 * 16;
    if (chas) { win_src((gw >> 4) * 32 + (lane & 31), csc, cscale); tr_load(P.w_in, NIN, (gw & 15) * 64, csc, cw, lane); }
    for (int m0 = gw; m0 < NTOK; m0 += 4 * NGW) { f32x4 v[4][4];
#pragma unroll
        for (int r = 0; r < 4; ++r) { const int m = min(m0 + r * NGW, NTOK - 1); const f32x4* xr = (const f32x4*)(P.x + (size_t)m * DM) + lane;
#pragma unroll
            for (int j = 0; j < 4; ++j) v[r][j] = xr[64 * j]; }
#pragma unroll
        for (int r = 0; r < 4; ++r) { const int m = m0 + r * NGW; if (m < NTOK) { u32x2* o = (u32x2*)(P.XB + (size_t)m * DM) + lane;
#pragma unroll
            for (int j = 0; j < 4; ++j) { u32x2 w; w.x = cvt_pk_bf16(v[r][j].x, v[r][j].y); w.y = cvt_pk_bf16(v[r][j].z, v[r][j].w); o[64 * j] = w; } } } }
    if (chas) tr_finish(cw, cscale, P.WIN, DM, (gw >> 4) * 32, (gw & 15) * 64, lane);
    for (int i = gw * 64 + lane; i < NTOK * 12; i += NGW * 64) { const int tok = i / 12, a = i % 12;
        const float inv = a < 8 ? exp2f(-(float)a * (18.931568569324174f / 8.f)) : exp2f(-(float)(a - 8) * (18.931568569324174f / 4.f));
        const float ang = (float)P.positions[tok] * inv;
        double rev = (double)ang * 0.15915494309189535; rev -= floor(rev); const float fr = (float)rev;
        const f32x2 cs = (f32x2){__builtin_amdgcn_cosf(fr), __builtin_amdgcn_sinf(fr)};
        if (a < 8) P.R16[tok * 8 + a] = cs; else P.R8[tok * 4 + (a - 8)] = cs; }
    for (int it = gw + NGW; it < 176 * 16; it += NGW) { const int ng = it >> 4, kb = it & 15, n0 = ng * 32; int sc; float scale; win_src(n0 + (lane & 31), sc, scale);
        tr_item(P.w_in, NIN, kb * 64, sc, scale, P.WIN, DM, n0, scr, lane); }
    for (int i = gw * 64 + lane; i < 8 * 256 * 64; i += NGW * 64) { const int dd = i & 63, r = (i >> 6) & 255, h = i >> 14;
        const float v = dd < 16 ? 0.f : P.g_kv[r] * P.w_uk[((size_t)r * 8 + h) * 48 + dd - 16]; P.WQ[i] = (bf16)(cvt_pk_bf16(v, 0.f) & 0xffffu); }
    for (int i = gw * 64 + lane; i < 8 * 64 * 256; i += NGW * 64) { const int r = i & 255, d = (i >> 8) & 63, h = i >> 14;
        const float v = P.g_kv[r] * P.w_uv[((size_t)r * 8 + h) * 64 + d]; P.WV[i] = (bf16)(cvt_pk_bf16(v, 0.f) & 0xffffu); }
    for (int it = (gw + NGW - 768 % NGW) % NGW; it < 8 * 32; it += NGW) { const int kb = it >> 5, nb = it & 31; tr_item(P.w_ba, DM, kb * 64, nb * 32 + (lane & 31), 1.f, P.WAB, 768, nb * 32, scr, lane); }
    for (int it = (gw + NGW - 1024 % NGW) % NGW; it < 4 * 32; it += NGW) { const int kb = it >> 5, nb = it & 31; tr_item(P.w_bb, DM, kb * 64, nb * 32 + (lane & 31), 1.f, P.WAB + 512, 768, nb * 32, scr, lane); }
    for (int it = (gw + NGW - 1152 % NGW) % NGW; it < 16 * 32; it += NGW) { const int kb = it >> 5, nb = it & 31; tr_item(P.w_o, DM, kb * 64, nb * 32 + (lane & 31), 1.f, P.WO, DM, nb * 32, scr, lane); }
}

struct EpiP1 {
    static constexpr bool PERM = true; static constexpr int MID_T = 0;
    Ptrs P;
    __device__ __forceinline__ void operator()(const f32x4 (&acc)[2][2][4][2], const gp::U& u, int wr, int wc, int fr, int fq) const {
        const int pn = u.c0, row0 = u.r0 + wr * 64 + fr, c8 = wc * 32 + 8 * fq;
#define P1_ROW(gi) (row0 + ((gi) >> 2) * 128 + ((gi) & 3) * 16)
        if (pn == 2) {
#pragma unroll
            for (int gi = 0; gi < 8; ++gi) { const int ai = gi >> 2, m = gi & 3; const int row = P1_ROW(gi); float ss = 0.f;
#pragma unroll
                for (int bj = 0; bj < 2; ++bj) { const f32x4 v0 = acc[ai][bj][m][0], v1 = acc[ai][bj][m][1];
                    ss += (v0.x * v0.x + v0.y * v0.y + v0.z * v0.z + v0.w * v0.w) + (v1.x * v1.x + v1.y * v1.y + v1.z * v1.z + v1.w * v1.w); st8(P.KV + (size_t)row * KVS + bj * 128 + c8, v0, v1); }
                ss += __shfl_xor(ss, 16); ss += __shfl_xor(ss, 32);
                if (fq == 0) ((float*)(P.KV + (size_t)row * KVS + 272))[wc] = ss; }
        } else if (pn == 3) {
            f32x4 ca[2], cb[2]; ca[0] = *(const f32x4*)(P.R8 + (size_t)row0 * 4); cb[0] = *(const f32x4*)(P.R8 + (size_t)row0 * 4 + 2);
#pragma unroll
            for (int gi = 0; gi < 8; ++gi) { const int ai = gi >> 2, m = gi & 3; const int row = P1_ROW(gi);
                if (gi < 7) { const int rn = P1_ROW(gi + 1); ca[(gi + 1) & 1] = *(const f32x4*)(P.R8 + (size_t)rn * 4); cb[(gi + 1) & 1] = *(const f32x4*)(P.R8 + (size_t)rn * 4 + 2); }
                asm volatile("" ::: "memory");
#pragma unroll
                for (int bj = 0; bj < 2; ++bj) { f32x4 v0 = acc[ai][bj][m][0], v1 = acc[ai][bj][m][1]; if (fq == 0) { v0 = rope4(v0, ca[gi & 1]); v1 = rope4(v1, cb[gi & 1]); } st8(P.IQ + (size_t)row * 256 + bj * 128 + c8, v0, v1); } }
        } else if (pn == 4) {
            const bool r16 = wc == 0 && fq < 2;
            const f32x2* tb = r16 ? P.R16 : P.R8; const int ts = r16 ? 8 : 4, to = r16 ? 4 * fq : 0;
            f32x4 ca[2], cb[2]; ca[0] = *(const f32x4*)(tb + (size_t)row0 * ts + to); cb[0] = *(const f32x4*)(tb + (size_t)row0 * ts + to + 2);
#pragma unroll
            for (int gi = 0; gi < 8; ++gi) { const int ai = gi >> 2, m = gi & 3; const int row = P1_ROW(gi);
                if (gi < 7) { const int rn = P1_ROW(gi + 1); ca[(gi + 1) & 1] = *(const f32x4*)(tb + (size_t)rn * ts + to); cb[(gi + 1) & 1] = *(const f32x4*)(tb + (size_t)rn * ts + to + 2); }
                asm volatile("" ::: "memory");
                const f32x4 v0 = acc[ai][0][m][0], v1 = acc[ai][0][m][1];
                if (wc == 0) {
                    if (fq < 2) st8(P.KV + (size_t)row * KVS + 256 + 8 * fq, rope4(v0, ca[gi & 1]), rope4(v1, cb[gi & 1]));
                    else if (fq == 2) st8(P.IK + (size_t)row * 32, rope4(v0, ca[gi & 1]), rope4(v1, cb[gi & 1]));
                    else st8(P.IK + (size_t)row * 32 + 8, v0, v1);
                } else if (wc == 1) {
                    if (fq < 2) st8(P.IK + (size_t)row * 32 + 16 + 8 * fq, v0, v1);
                    else if (fq == 2) { *(f32x4*)(P.IW + (size_t)row * 8) = v0; *(f32x4*)(P.IW + (size_t)row * 8 + 4) = v1; }
                } }
        } else if (pn < 11) {
            const bool rp = (wc & 1) == 0 && fq < 2;
            bf16* dst0 = pn < 2 ? P.AQ + pn * 256 : (pn < 8 ? P.BQ + (pn - 5) * 256 : P.BK + (pn - 8) * 256); const int ldd = pn < 2 ? 512 : 768;
            f32x4 ca[2], cb[2]; ca[0] = *(const f32x4*)(P.R16 + (size_t)row0 * 8 + 4 * (fq & 1)); cb[0] = *(const f32x4*)(P.R16 + (size_t)row0 * 8 + 4 * (fq & 1) + 2);
#pragma unroll
            for (int gi = 0; gi < 8; ++gi) { const int ai = gi >> 2, m = gi & 3; const int row = P1_ROW(gi);
                if (gi < 7) { const int rn = P1_ROW(gi + 1); ca[(gi + 1) & 1] = *(const f32x4*)(P.R16 + (size_t)rn * 8 + 4 * (fq & 1)); cb[(gi + 1) & 1] = *(const f32x4*)(P.R16 + (size_t)rn * 8 + 4 * (fq & 1) + 2); }
                asm volatile("" ::: "memory");
#pragma unroll
                for (int bj = 0; bj < 2; ++bj) { f32x4 v0 = acc[ai][bj][m][0], v1 = acc[ai][bj][m][1]; if (rp) { v0 = rope4(v0, ca[gi & 1]); v1 = rope4(v1, cb[gi & 1]); } st8(dst0 + (size_t)row * ldd + bj * 128 + c8, v0, v1); } }
        } else if (pn < 14) {
#pragma unroll
            for (int gi = 0; gi < 8; ++gi) { const int ai = gi >> 2, m = gi & 3; const int row = P1_ROW(gi);
#pragma unroll
                for (int bj = 0; bj < 2; ++bj) st8(P.BV + (size_t)row * 768 + (pn - 11) * 256 + bj * 128 + c8, acc[ai][bj][m][0], acc[ai][bj][m][1]); }
        } else {
            const int gc0 = (pn - 14) * 256 + 64 * wc + 16 * fq;
            f32x4 bg[2][2];
#pragma unroll
            for (int bj = 0; bj < 2; ++bj)
#pragma unroll
                for (int n = 0; n < 2; ++n) bg[bj][n] = *(const f32x4*)(P.b_gate + gc0 + 8 * bj + 4 * n);
            asm volatile("" : "+v"(bg[0][0]), "+v"(bg[0][1]), "+v"(bg[1][0]), "+v"(bg[1][1]));
#pragma unroll
            for (int gi = 0; gi < 8; ++gi) { const int ai = gi >> 2, m = gi & 3; const int row = P1_ROW(gi); u32x4 pk; unsigned pw[4];
#pragma unroll
                for (int bj = 0; bj < 2; ++bj)
#pragma unroll
                    for (int n = 0; n < 2; ++n) { f32x4 v = acc[ai][bj][m][n] + bg[bj][n];
                        v.x = __builtin_amdgcn_rcpf(1.f + __expf(-v.x)); v.y = __builtin_amdgcn_rcpf(1.f + __expf(-v.y)); v.z = __builtin_amdgcn_rcpf(1.f + __expf(-v.z)); v.w = __builtin_amdgcn_rcpf(1.f + __expf(-v.w));
                        pw[2 * bj + n] = pk4_fp8(fmaxf(v.x, 0.001953125f), fmaxf(v.y, 0.001953125f), fmaxf(v.z, 0.001953125f), fmaxf(v.w, 0.001953125f)); }
                pk.x = pw[0]; pk.y = pw[1]; pk.z = pw[2]; pk.w = pw[3];
                *(u32x4*)(P.G + (size_t)row * 2048 + gc0) = pk; }
        }
#undef P1_ROW
    }
};

template <int K, int N, class GF>
__device__ __forceinline__ void headgemm_wave(const bf16* X, int ldx, const bf16* W, bf16* OUT, int ldo, const GF& gf, int ngrp, int lane) {
    const int fr = lane & 15, fq = lane >> 4;
    bf16x8 wf[N / 16][K / 32];
#pragma unroll
    for (int nt = 0; nt < N / 16; ++nt)
#pragma unroll
        for (int s = 0; s < K / 32; ++s) wf[nt][s] = *(const bf16x8*)(W + (size_t)(32 * (nt >> 1) + 8 * (fr >> 2) + 4 * (nt & 1) + (fr & 3)) * K + 32 * s + 8 * fq);
    bf16x8 xn[K / 32];
#pragma unroll
    for (int s = 0; s < K / 32; ++s) xn[s] = *(const bf16x8*)(X + ((size_t)gf(0) * 16 + fr) * ldx + 32 * s + 8 * fq);
#pragma nounroll
    for (int gi = 0; gi < ngrp; ++gi) { const int t16 = gf(gi);
        bf16x8 xf[K / 32];
#pragma unroll
        for (int s = 0; s < K / 32; ++s) xf[s] = xn[s];
        const int tn = gf(min(gi + 1, ngrp - 1));
#pragma unroll
        for (int s = 0; s < K / 32; ++s) xn[s] = *(const bf16x8*)(X + ((size_t)tn * 16 + fr) * ldx + 32 * s + 8 * fq);
        bf16* op = OUT + ((size_t)t16 * 16 + fr) * ldo + 8 * fq;
#pragma unroll
        for (int np = 0; np < N / 32; ++np) {
            f32x4 a0 = (f32x4){0.f, 0.f, 0.f, 0.f}, a1 = (f32x4){0.f, 0.f, 0.f, 0.f};
#pragma unroll
            for (int s = 0; s < K / 32; ++s) { a0 = __builtin_amdgcn_mfma_f32_16x16x32_bf16(wf[2 * np][s], xf[s], a0, 0, 0, 0); a1 = __builtin_amdgcn_mfma_f32_16x16x32_bf16(wf[2 * np + 1][s], xf[s], a1, 0, 0, 0); }
            st8(op + 32 * np, a0, a1);
        }
    }
}

struct EpiUV {
    static constexpr bool PERM = true; static constexpr int MID_T = 8;
    const unsigned char* G; bf16* MP;
    __device__ __forceinline__ void mid(f32x4 (&acc)[2][2][4][2], const gp::U& u, int wr, int wc, int fr, int fq) const {
        unsigned off = (unsigned)((u.r0 + wr * 64 + fr) * 2048 + u.c0 * 256 + wc * 32 + 8 * fq);
        asm volatile("" : "+v"(off));
#pragma unroll
        for (int bt = 0; bt < 4; ++bt) { u32x2 ga[4], gb[4];
#pragma unroll
            for (int k = 0; k < 4; ++k) { const int i = 4 * bt + k, gi = i >> 1, bj = i & 1; const unsigned o = off + (unsigned)(((gi >> 2) * 128 + (gi & 3) * 16) * 2048 + bj * 128); ga[k] = *(const u32x2*)(G + o); gb[k] = *(const u32x2*)(G + (o + 1024u)); }
            asm volatile("" ::: "memory");
#pragma unroll
            for (int k = 0; k < 4; ++k) { const int i = 4 * bt + k, gi = i >> 1, bj = i & 1, ai = gi >> 2, m = gi & 3;
                const f32x4 b0 = up4_fp8(gb[k].x), b1 = up4_fp8(gb[k].y);
                acc[ai][bj][m][0] = acc[ai][bj][m][0] * (up4_fp8(ga[k].x) * (f32x4){__builtin_amdgcn_rcpf(b0.x), __builtin_amdgcn_rcpf(b0.y), __builtin_amdgcn_rcpf(b0.z), __builtin_amdgcn_rcpf(b0.w)});
                acc[ai][bj][m][1] = acc[ai][bj][m][1] * (up4_fp8(ga[k].y) * (f32x4){__builtin_amdgcn_rcpf(b1.x), __builtin_amdgcn_rcpf(b1.y), __builtin_amdgcn_rcpf(b1.z), __builtin_amdgcn_rcpf(b1.w)}); }
            __builtin_amdgcn_sched_barrier(0); }
    }
    __device__ __forceinline__ void operator()(const f32x4 (&acc)[2][2][4][2], const gp::U& u, int wr, int wc, int fr, int fq) const {
        const int row0 = u.r0 + wr * 64 + fr, col0 = u.c0 * 256 + wc * 32 + 8 * fq;
        u32x2 g[2][2];
#pragma unroll
        for (int bj = 0; bj < 2; ++bj) g[0][bj] = *(const u32x2*)(G + (size_t)row0 * 2048 + 1024 + col0 + bj * 128);
#pragma unroll
        for (int gi = 0; gi < 8; ++gi) { const int ai = gi >> 2, m = gi & 3; const size_t row = row0 + ai * 128 + m * 16;
            if (gi < 7) { const size_t rn = row0 + ((gi + 1) >> 2) * 128 + ((gi + 1) & 3) * 16;
#pragma unroll
                for (int bj = 0; bj < 2; ++bj) g[(gi + 1) & 1][bj] = *(const u32x2*)(G + rn * 2048 + 1024 + col0 + bj * 128); }
            asm volatile("" ::: "memory");
#pragma unroll
            for (int bj = 0; bj < 2; ++bj) { const u32x2 w = g[gi & 1][bj];
                st8(MP + row * DM + col0 + bj * 128, acc[ai][bj][m][0] * up4_fp8(w.x), acc[ai][bj][m][1] * up4_fp8(w.y)); } }
    }
};
struct EpiO {
    static constexpr bool PERM = false; static constexpr int MID_T = 0;
    const float* x; float* PRE;
    __device__ __forceinline__ void operator()(const f32x4 (&acc)[2][2][4][2], const gp::U& u, int wr, int wc, int fr, int fq) const {
        const int row0 = u.r0 + wr * 64 + fr, col0 = u.c0 * 256 + wc * 32 + 4 * fq;
        f32x4 xv[2][2][2];
#pragma unroll
        for (int bj = 0; bj < 2; ++bj)
#pragma unroll
            for (int n = 0; n < 2; ++n) xv[0][bj][n] = *(const f32x4*)(x + (size_t)row0 * DM + col0 + bj * 128 + n * 16);
#pragma unroll
        for (int gi = 0; gi < 8; ++gi) { const int ai = gi >> 2, m = gi & 3; const size_t row = row0 + ai * 128 + m * 16;
            if (gi < 7) { const size_t rn = row0 + ((gi + 1) >> 2) * 128 + ((gi + 1) & 3) * 16;
#pragma unroll
                for (int bj = 0; bj < 2; ++bj)
#pragma unroll
                    for (int n = 0; n < 2; ++n) xv[(gi + 1) & 1][bj][n] = *(const f32x4*)(x + rn * DM + col0 + bj * 128 + n * 16); }
            asm volatile("" ::: "memory");
#pragma unroll
            for (int bj = 0; bj < 2; ++bj)
#pragma unroll
                for (int n = 0; n < 2; ++n) *(f32x4*)(PRE + row * DM + col0 + bj * 128 + n * 16) = xv[gi & 1][bj][n] * ALPHA + acc[ai][bj][m][n]; }
    }
};

constexpr int YCAP_BLK = (int)((WS_HB - WS_Y) / (256 * 1024));
struct MoeTab { LAS int* pre; LAS int* cnt; };
__device__ __forceinline__ void moe_table(const Ptrs& P, MoeTab T) {
    if (threadIdx.x < 64) { const int e = threadIdx.x; const int c = (int)__hip_atomic_load(P.ctl + CW_CNT + 64 * e, __ATOMIC_RELAXED, __HIP_MEMORY_SCOPE_AGENT);
        const int blk = (c + 255) >> 8; int incl = blk;
#pragma unroll
        for (int o = 1; o < 64; o <<= 1) { const int t = __shfl_up(incl, o); incl += e >= o ? t : 0; }
        T.cnt[e] = c; T.pre[e] = incl - blk;
        if (e == 63) { T.cnt[64] = NTOK; T.pre[64] = incl; T.pre[65] = incl + NTOK / 256; } }
    __syncthreads();
}
struct MoeOrder1 {
    const bf16* HBF; const bf16* W13; const int* LIST; MoeTab T; int G, c;
    __device__ __forceinline__ bool next(int i, gp::U& u) const {
        const int L = i * G + c; const int total = __builtin_amdgcn_readfirstlane(T.pre[65]) * 2; if (L >= total) return false;
        const int blk = L >> 1, j = L & 1; int e = 0;
        for (int q = 64; q >= 1; q >>= 1) if (e + q <= 64 && __builtin_amdgcn_readfirstlane(T.pre[e + q]) <= blk) e += q;
        const int rb = blk - __builtin_amdgcn_readfirstlane(T.pre[e]);
        u.A = (const char*)HBF; u.B = (const char*)(W13 + ((size_t)e * 512 + j * 256) * DM);
        u.rows = e < 64 ? LIST + (size_t)e * NTOK + rb * 256 : nullptr; u.rbase = rb * 256; u.nvalid = min(256, __builtin_amdgcn_readfirstlane(T.cnt[e]) - rb * 256);
        u.r0 = blk * 256; u.c0 = j; u.x0 = e; u.x1 = rb;
        return true;
    }
};
struct EpiM1 {
    static constexpr bool PERM = true; static constexpr int MID_T = 0;
    bf16* HB; const float* WLIST;
    __device__ __forceinline__ void operator()(const f32x4 (&acc)[2][2][4][2], const gp::U& u, int wr, int wc, int fr, int fq) const {
        const int row0 = u.r0 + wr * 64 + fr, col0 = u.c0 * 128 + wc * 32 + 8 * fq;
        float w[8];
        if (u.x0 < 64) { const float* wl = WLIST + (size_t)u.x0 * NTOK + u.x1 * 256;
#pragma unroll
            for (int gi = 0; gi < 8; ++gi) { const int rl = wr * 64 + fr + (gi >> 2) * 128 + (gi & 3) * 16; w[gi] = wl[min(rl, u.nvalid - 1)]; } }
        else {
#pragma unroll
            for (int gi = 0; gi < 8; ++gi) w[gi] = 1.f; }
        asm volatile("" : "+v"(w[0]), "+v"(w[1]), "+v"(w[2]), "+v"(w[3]), "+v"(w[4]), "+v"(w[5]), "+v"(w[6]), "+v"(w[7]));
#pragma unroll
        for (int ai = 0; ai < 2; ++ai)
#pragma unroll
            for (int m = 0; m < 4; ++m) { const size_t row = row0 + ai * 128 + m * 16; const float ww = w[ai * 4 + m]; f32x4 v[2];
#pragma unroll
                for (int n = 0; n < 2; ++n) { const f32x4 a = acc[ai][0][m][n], b = acc[ai][1][m][n] * ww;
                    v[n].x = a.x * __builtin_amdgcn_rcpf(1.f + __expf(-a.x)) * b.x; v[n].y = a.y * __builtin_amdgcn_rcpf(1.f + __expf(-a.y)) * b.y;
                    v[n].z = a.z * __builtin_amdgcn_rcpf(1.f + __expf(-a.z)) * b.z; v[n].w = a.w * __builtin_amdgcn_rcpf(1.f + __expf(-a.w)) * b.w; }
                st8(HB + row * 256 + col0, v[0], v[1]); }
    }
};
struct MoeOrder2 {
    const bf16* HB; const bf16* W2; MoeTab T; int G, c, e_lo, e_hi;
    __device__ __forceinline__ bool next(int i, gp::U& u) const {
        const int L = i * G + c; const int b0 = __builtin_amdgcn_readfirstlane(T.pre[e_lo]), total = (__builtin_amdgcn_readfirstlane(T.pre[e_hi]) - b0) * 4; if (L >= total) return false;
        const int blk = b0 + (L >> 2), jn = L & 3; int e = 0;
        for (int q = 64; q >= 1; q >>= 1) if (e + q <= 64 && __builtin_amdgcn_readfirstlane(T.pre[e + q]) <= blk) e += q;
        const int rb = blk - __builtin_amdgcn_readfirstlane(T.pre[e]);
        u.A = (const char*)(HB + (size_t)blk * 256 * 256); u.B = (const char*)(W2 + ((size_t)e * 1024 + jn * 256) * 256);
        u.rows = nullptr; u.rbase = 0; u.nvalid = min(256, __builtin_amdgcn_readfirstlane(T.cnt[e]) - rb * 256);
        u.r0 = (blk - b0) * 256; u.c0 = jn; u.x0 = e; u.x1 = rb;
        return true;
    }
};
constexpr int LDS_XCH = 139264;
struct EpiM2R {
    static constexpr bool PERM = true; static constexpr int MID_T = 0;
    unsigned char* Y; const float* WLIST; LAS unsigned char* lds;
    __device__ __forceinline__ void operator()(const f32x4 (&acc)[2][2][4][2], const gp::U& u, int wr, int wc, int fr, int fq) const {
        const int lane = fr + 16 * fq;
        const int wch = 4 * wc + fq;
        LAS unsigned char* wp0 = lds + LDS_XCH + wr * 4096 + fr * 256 + ((((wch) >> 1) ^ fr) << 4) + ((wch & 1) << 3);
        LAS unsigned char* wp1 = lds + LDS_XCH + wr * 4096 + fr * 256 + ((((16 + wch) >> 1) ^ fr) << 4) + ((wch & 1) << 3);
        const int rr = 4 * wc + (lane >> 4), rch = lane & 15;
        const LAS unsigned char* rp = lds + LDS_XCH + wr * 4096 + rr * 256 + ((rch ^ rr) << 4);
        unsigned char* ybase = Y + (size_t)(u.r0 + wr * 64 + rr) * DM + u.c0 * 256 + 16 * rch;
#pragma unroll
        for (int gi = 0; gi < 8; ++gi) { const int ai = gi >> 2, m = gi & 3;
            { const f32x4 a = acc[ai][0][m][0] * YSCALE, b = acc[ai][0][m][1] * YSCALE; u32x2 pk; pk.x = pk4_fp8(a.x, a.y, a.z, a.w); pk.y = pk4_fp8(b.x, b.y, b.z, b.w); *(LAS u32x2*)(wp0 + (gi & 1) * 8192) = pk; }
            { const f32x4 a = acc[ai][1][m][0] * YSCALE, b = acc[ai][1][m][1] * YSCALE; u32x2 pk; pk.x = pk4_fp8(a.x, a.y, a.z, a.w); pk.y = pk4_fp8(b.x, b.y, b.z, b.w); *(LAS u32x2*)(wp1 + (gi & 1) * 8192) = pk; }
            LDS_WAIT(); __builtin_amdgcn_s_barrier(); asm volatile("" ::: "memory");
            const u32x4 o = *(const LAS u32x4*)(rp + (gi & 1) * 8192);
            const int rl = wr * 64 + ai * 128 + m * 16 + rr;
            if (rl < u.nvalid) __builtin_nontemporal_store(o, (u32x4*)(ybase + (size_t)(ai * 128 + m * 16) * DM)); }
    }
};
struct EpiM2S {
    static constexpr bool PERM = false; static constexpr int MID_T = 0;
    float* ACC;
    __device__ __forceinline__ void operator()(const f32x4 (&acc)[2][2][4][2], const gp::U& u, int wr, int wc, int fr, int fq) const {
        const int row0 = u.x1 * 256 + wr * 64 + fr, col0 = u.c0 * 256 + wc * 32 + 4 * fq;
        f32x4 xv[2][2][2];
#pragma unroll
        for (int bj = 0; bj < 2; ++bj)
#pragma unroll
            for (int n = 0; n < 2; ++n) xv[0][bj][n] = *(const f32x4*)(ACC + (size_t)row0 * DM + col0 + bj * 128 + n * 16);
#pragma unroll
        for (int gi = 0; gi < 8; ++gi) { const int ai = gi >> 2, m = gi & 3; const size_t row = row0 + ai * 128 + m * 16;
            if (gi < 7) { const size_t rn = row0 + ((gi + 1) >> 2) * 128 + ((gi + 1) & 3) * 16;
#pragma unroll
                for (int bj = 0; bj < 2; ++bj)
#pragma unroll
                    for (int n = 0; n < 2; ++n) xv[(gi + 1) & 1][bj][n] = *(const f32x4*)(ACC + rn * DM + col0 + bj * 128 + n * 16); }
            asm volatile("" ::: "memory");
#pragma unroll
            for (int bj = 0; bj < 2; ++bj)
#pragma unroll
                for (int n = 0; n < 2; ++n) *(f32x4*)(ACC + row * DM + col0 + bj * 128 + n * 16) = xv[gi & 1][bj][n] + acc[ai][bj][m][n]; }
    }
};

__device__ __forceinline__ void expert_weights(const Ptrs& P, LAS unsigned char* lds, int gw, int NGW, int wave, int lane) {
    LAS float* scr = (LAS float*)(lds + wave * 16384);
    for (int it = gw; it < 65 * 256; it += NGW) { const int e = it >> 8, r = it & 255;
        const int which = r >> 7, q = r & 127, kb = q >> 3, cb = q & 7, c0 = cb * 32;
        const float* W = e < 64 ? (which ? P.w3_e : P.w1_e) + (size_t)e * DM * DEXP : (which ? P.ws3 : P.ws1);
        float v[32]; tr_load(W, DEXP, kb * 64, c0 + (lane & 31), v, lane); tr_finish(v, 1.f, P.W13 + (size_t)e * 512 * DM, DM, 256 * (c0 >> 7) + (c0 & 127) + which * 128, kb * 64, lane); }
}
__device__ __forceinline__ void expert_weights_w2(const Ptrs& P, LAS unsigned char* lds, int wave, int lane) {
    LAS float* scr = (LAS float*)(lds + wave * 16384); LAS int* slot = (LAS int*)(lds + 135168 + 1024);
#pragma nounroll
    for (;;) {
        if (threadIdx.x == 0) *slot = (int)__hip_atomic_fetch_add(P.ctl + CW_W2Q, 8u, __ATOMIC_RELAXED, __HIP_MEMORY_SCOPE_AGENT);
        __syncthreads();
        const int it = *slot + wave;
        __syncthreads();
        if (it - wave >= 65 * 128) break;
        const int e = it >> 7, q = it & 127, kb = q >> 5, nb = q & 31;
        const float* W = e < 64 ? P.w2_e + (size_t)e * DEXP * DM : P.ws2;
        float v[32]; tr_load(W, DM, kb * 64, nb * 32 + (lane & 31), v, lane); tr_finish(v, 1.f, P.W2 + (size_t)e * DM * DEXP, DEXP, nb * 32, kb * 64, lane); }
}

__device__ __forceinline__ void w13_load(const Ptrs& P, int it, float (&v)[32], int lane) {
    const int e = it >> 8, r = it & 255, which = r >> 7, q = r & 127, kb = q >> 3, c0 = (q & 7) * 32;
    const float* W = e < 64 ? (which ? P.w3_e : P.w1_e) + (size_t)e * DM * DEXP : (which ? P.ws3 : P.ws1);
    tr_load(W, DEXP, kb * 64, c0 + (lane & 31), v, lane);
}
__device__ __forceinline__ void w13_finish(const Ptrs& P, int it, const float (&v)[32], int lane) {
    const int e = it >> 8, r = it & 255, which = r >> 7, q = r & 127, kb = q >> 3, c0 = (q & 7) * 32;
    tr_finish(v, 1.f, P.W13 + (size_t)e * 512 * DM, DM, 256 * (c0 >> 7) + (c0 & 127) + which * 128, kb * 64, lane);
}
constexpr int L1_HT = 0, L1_PART = 66048, L1_RTOK = 98816, L1_RER = 102912, L1_RW = 107008, L1_LCNT = 111104, L1_BASE = 111360;
__device__ __forceinline__ void ln1_router_phase(const Ptrs& P, LAS unsigned char* lds, int vcu, int G, int gw, int NGW, int wave, int lane) {
    LAS float* hT = (LAS float*)(lds + L1_HT); LAS float* PART = (LAS float*)(lds + L1_PART);
    LAS int* rtok = (LAS int*)(lds + L1_RTOK); LAS int* rer = (LAS int*)(lds + L1_RER); LAS float* rw = (LAS float*)(lds + L1_RW);
    LAS int* lcnt = (LAS int*)(lds + L1_LCNT); LAS int* base = (LAS int*)(lds + L1_BASE);
    const int tid = threadIdx.x;
    if (tid < 64) lcnt[tid] = 0;
    __syncthreads();
    int nrec = 0;
    const int ngroups = NTOK / 16;
    int gi = 0;
    f32x4 nv[2][4];
#pragma unroll
    for (int rr = 0; rr < 2; ++rr)
#pragma unroll
        for (int j = 0; j < 4; ++j) nv[rr][j] = *((const f32x4*)(P.out + ((size_t)min(vcu, ngroups - 1) * 16 + 2 * wave + rr) * DM) + lane + 64 * j);
    float cw[32];
    const float rbias = P.router_bias[lane];
    for (int grp = vcu; grp < ngroups; grp += G, ++gi) {
        const int cit = gw + gi * NGW; const bool chas = cit < 65 * 256;
#pragma unroll
        for (int rr = 0; rr < 2; ++rr) {
            const int rloc = 2 * wave + rr; const size_t row = (size_t)grp * 16 + rloc;
            f32x4 v[4]; float s = 0.f;
#pragma unroll
            for (int j = 0; j < 4; ++j) { v[j] = nv[rr][j]; s += (v[j].x + v[j].y) + (v[j].z + v[j].w); }
            const float mean = wave_sum(s) * (1.f / DM); float s2 = 0.f;
#pragma unroll
            for (int j = 0; j < 4; ++j) { v[j] = v[j] - mean; s2 += (v[j].x * v[j].x + v[j].y * v[j].y) + (v[j].z * v[j].z + v[j].w * v[j].w); }
            const float rstd = 1.f / sqrtf(wave_sum(s2) * (1.f / DM) + LN_EPS);
#pragma unroll
            for (int j = 0; j < 4; ++j) { const int c = 4 * lane + 256 * j; const f32x4 g = *(const f32x4*)(P.ln1_g + c), b = *(const f32x4*)(P.ln1_b + c);
                const f32x4 h = v[j] * rstd * g + b;
                st4(P.HBF + row * (2 * DM) + c, h);
                *(LAS f32x4*)(hT + rloc * 1028 + c) = h; }
        }
        { const int gn = grp + G < ngroups ? grp + G : grp;
#pragma unroll
          for (int rr = 0; rr < 2; ++rr)
#pragma unroll
              for (int j = 0; j < 4; ++j) nv[rr][j] = *((const f32x4*)(P.out + ((size_t)gn * 16 + 2 * wave + rr) * DM) + lane + 64 * j); }
        __syncthreads();
        if (gi > 0 && cit - NGW < 65 * 256) w13_finish(P, cit - NGW, cw, lane);
        f32x4 z[4] = {(f32x4){0.f, 0.f, 0.f, 0.f}, (f32x4){0.f, 0.f, 0.f, 0.f}, (f32x4){0.f, 0.f, 0.f, 0.f}, (f32x4){0.f, 0.f, 0.f, 0.f}};
        {
            const int fr = lane & 15, fq = lane >> 4;
            const LAS float* ap = hT + fr * 1028 + 128 * wave + fq;
            const float* bp = P.w_router + (size_t)(128 * wave + fq) * 64 + fr;
#pragma unroll 4
            for (int s = 0; s < 32; ++s) { const float a = ap[4 * s];
#pragma unroll
                for (int jt = 0; jt < 4; ++jt) z[jt] = __builtin_amdgcn_mfma_f32_16x16x4f32(a, bp[(size_t)(4 * s) * 64 + 16 * jt], z[jt], 0, 0, 0); }
#pragma unroll
            for (int jt = 0; jt < 4; ++jt)
#pragma unroll
                for (int jj = 0; jj < 4; ++jj) PART[(wave * 16 + 4 * fq + jj) * 64 + 16 * jt + fr] = z[jt][jj];
        }
        if (chas) w13_load(P, cit, cw, lane);
        __syncthreads();
#pragma unroll
        for (int rr = 0; rr < 2; ++rr) {
            const int rloc = 2 * wave + rr; const int tok = grp * 16 + rloc;
            float logit = 0.f;
#pragma unroll
            for (int w2 = 0; w2 < 8; ++w2) logit += PART[(w2 * 16 + rloc) * 64 + lane];
            const float score = 1.f / (1.f + expf(-logit));
            const float biased = score + rbias;
            float m1 = biased;
#pragma unroll
            for (int o = 1; o < 8; o <<= 1) m1 = fmaxf(m1, __shfl_xor(m1, o));
            const unsigned long long is1 = __ballot(biased == m1);
            const int gbase = lane & ~7; const unsigned gm = (unsigned)((is1 >> gbase) & 0xffull);
            const int first = gbase + __builtin_ctz(gm);
            float m2 = lane == first ? -INFINITY : biased;
#pragma unroll
            for (int o = 1; o < 8; o <<= 1) m2 = fmaxf(m2, __shfl_xor(m2, o));
            const float gs = m1 + m2;
            int grank = 0; const int mygrp = lane >> 3;
#pragma unroll
            for (int g2 = 0; g2 < 8; ++g2) { const float o = __shfl(gs, 8 * g2); grank += (o > gs || (o == gs && g2 < mygrp)) ? 1 : 0; }
            const float mv = grank < 4 ? biased : -INFINITY;
            int rank = 0;
            { LAS float* mvs = PART + (wave * 2 + rr) * 64;
              LDS_WAIT(); mvs[lane] = mv; LDS_WAIT();
#pragma unroll
              for (int l4 = 0; l4 < 16; ++l4) { const f32x4 o = *(const LAS f32x4*)(mvs + 4 * l4);
                  rank += (o.x > mv || (o.x == mv && 4 * l4 < lane)) ? 1 : 0; rank += (o.y > mv || (o.y == mv && 4 * l4 + 1 < lane)) ? 1 : 0;
                  rank += (o.z > mv || (o.z == mv && 4 * l4 + 2 < lane)) ? 1 : 0; rank += (o.w > mv || (o.w == mv && 4 * l4 + 3 < lane)) ? 1 : 0; } }
            const bool sel = rank < 8;
            const float ssum = wave_sum(sel ? score : 0.f);
            const float w = score / ssum * 2.5f;
            const unsigned long long selm = __ballot(sel);
            if (sel) { const int k = __popcll(selm & ((1ull << lane) - 1ull));
                const int lr = __hip_atomic_fetch_add(&lcnt[lane], 1, __ATOMIC_RELAXED, __HIP_MEMORY_SCOPE_WORKGROUP);
                const int ri = (gi * 16 + rloc) * 8 + k;
                rtok[ri] = tok * 8 + k; rer[ri] = (lane << 16) | lr; rw[ri] = w; }
        }
        __syncthreads();
    }
    if (gi > 0 && gw + (gi - 1) * NGW < 65 * 256) w13_finish(P, gw + (gi - 1) * NGW, cw, lane);
    for (int cit = gw + gi * NGW; cit < 65 * 256; cit += NGW) { w13_load(P, cit, cw, lane); w13_finish(P, cit, cw, lane); }
    (void)nrec;
    if (tid < 64) base[tid] = (int)__hip_atomic_fetch_add(P.ctl + CW_CNT + 64 * tid, (unsigned)lcnt[tid], __ATOMIC_RELAXED, __HIP_MEMORY_SCOPE_AGENT);
    __syncthreads();
    const int nr = gi * 128;
    for (int i = tid; i < nr; i += NWAVES * 64) { const int tk = rtok[i], er = rer[i], e = er >> 16, pos = base[e] + (er & 0xffff);
        P.LIST[(size_t)e * NTOK + pos] = tk >> 3; P.WLIST[(size_t)e * NTOK + pos] = rw[i]; P.REC[tk] = (unsigned)((e << 16) | pos); }
    __syncthreads();
}

template <bool FINAL>
__device__ __forceinline__ void combine_phase(const Ptrs& P, MoeTab T, int e_lo, int e_hi, int gw, int NGW, int lane) {
    const int b0 = T.pre[e_lo], q = lane >> 4, l16 = lane & 15;
#pragma nounroll
    for (int t0 = gw * 4; t0 < NTOK; t0 += NGW * 4) {
        const int tok = t0 + q;
        float* orow = P.out + (size_t)tok * DM + 8 * l16;
        f32x4 v[8][2];
#pragma unroll
        for (int j = 0; j < 8; ++j) { ld8bf(P.HBF + (size_t)tok * (2 * DM) + 8 * l16 + 128 * j, v[j][0], v[j][1]); v[j][0] = v[j][0] * ALPHA; v[j][1] = v[j][1] * ALPHA; }
        const unsigned rec = P.REC[tok * 8 + (lane & 7)];
#pragma unroll
        for (int k = 0; k < 8; ++k) { const unsigned r = __shfl(rec, (lane & 48) + k); const int e = (int)(r >> 16), pos = (int)(r & 0xffffu);
            if (e >= e_lo && e < e_hi) { const unsigned char* y = (const unsigned char*)P.Y + ((size_t)(T.pre[e] - b0) * 256 + pos) * DM + 8 * l16;
#pragma unroll
                for (int j = 0; j < 8; ++j) { const u32x2 w = *(const u32x2*)(y + 128 * j); v[j][0] = v[j][0] + up4_fp8(w.x) * (1.f / YSCALE); v[j][1] = v[j][1] + up4_fp8(w.y) * (1.f / YSCALE); } } }
        { const unsigned char* y = (const unsigned char*)P.Y + ((size_t)(T.pre[64] - b0) * 256 + tok) * DM + 8 * l16;
#pragma unroll
          for (int j = 0; j < 8; ++j) { const u32x2 w = *(const u32x2*)(y + 128 * j); v[j][0] = v[j][0] + up4_fp8(w.x) * (1.f / YSCALE); v[j][1] = v[j][1] + up4_fp8(w.y) * (1.f / YSCALE); } }
        if (FINAL) {
            float s = 0.f;
#pragma unroll
            for (int j = 0; j < 8; ++j) s += ((v[j][0].x + v[j][0].y) + (v[j][0].z + v[j][0].w)) + ((v[j][1].x + v[j][1].y) + (v[j][1].z + v[j][1].w));
#pragma unroll
            for (int o = 1; o < 16; o <<= 1) s += __shfl_xor(s, o);
            const float mean = s * (1.f / DM); float s2 = 0.f;
#pragma unroll
            for (int j = 0; j < 8; ++j) { v[j][0] = v[j][0] - mean; v[j][1] = v[j][1] - mean;
                s2 += ((v[j][0].x * v[j][0].x + v[j][0].y * v[j][0].y) + (v[j][0].z * v[j][0].z + v[j][0].w * v[j][0].w)) + ((v[j][1].x * v[j][1].x + v[j][1].y * v[j][1].y) + (v[j][1].z * v[j][1].z + v[j][1].w * v[j][1].w)); }
#pragma unroll
            for (int o = 1; o < 16; o <<= 1) s2 += __shfl_xor(s2, o);
            const float rstd = 1.f / sqrtf(s2 * (1.f / DM) + LN_EPS);
#pragma unroll
            for (int j = 0; j < 8; ++j) { const int c = 8 * l16 + 128 * j;
                v[j][0] = v[j][0] * rstd * *(const f32x4*)(P.ln2_g + c) + *(const f32x4*)(P.ln2_b + c); v[j][1] = v[j][1] * rstd * *(const f32x4*)(P.ln2_g + c + 4) + *(const f32x4*)(P.ln2_b + c + 4); }
        }
#pragma unroll
        for (int j = 0; j < 8; ++j) { *(f32x4*)(orow + 128 * j) = v[j][0]; *(f32x4*)(orow + 128 * j + 4) = v[j][1]; }
    }
}

constexpr int VST = 144;
__device__ __forceinline__ void mixb_item(const Ptrs& P, LAS unsigned char* wl, int b, int tb, int c, int j, int lane) {
    const int fr = lane & 15, fq = lane >> 4;
    const int t0 = tb * 256 + c; const size_t rowb = (size_t)b * SEQ;
    const int tq = t0 + 16 * fr;
    float m = -INFINITY, lsum = 0.f;
    f32x4 O[4] = {(f32x4){0.f, 0.f, 0.f, 0.f}, (f32x4){0.f, 0.f, 0.f, 0.f}, (f32x4){0.f, 0.f, 0.f, 0.f}, (f32x4){0.f, 0.f, 0.f, 0.f}};
    const unsigned tr_base = (unsigned)(size_t)wl + (unsigned)((4 * fq + (fr >> 2)) * VST + (fr & 3) * 8);
#pragma nounroll
    for (int g = 0; g < 3; ++g) {
        const int d = g == 0 ? 1 : (g == 1 ? 4 : 16), sq = 16 / d, hh = 4 * g + j;
        const int NP = (((129 + 15 * sq + 15) >> 4) + 1) >> 1;
        const bf16* qp = P.BQ + (rowb + tq) * 768 + hh * 64 + 8 * fq;
        const bf16x8 q0 = *(const bf16x8*)qp, q1 = *(const bf16x8*)(qp + 32);
        const int relq = fr * sq;
        const char* kb = (const char*)(P.BK + rowb * 768 + hh * 64); const char* vb = (const char*)(P.BV + rowb * 768 + hh * 64);
        const unsigned klane = 16u * fq, vlane = 16u * (lane & 7);
        bf16x8 ka0, ka1, kb0, kb1; u32x4 v0, v1, v2, v3;
#define MIXB_LOAD(r0) do { \
        const int kpa = min(max(t0 + d * ((r0) + fr), 0), SEQ - 1), kpb = min(max(t0 + d * ((r0) + 16 + fr), 0), SEQ - 1); \
        const unsigned oa = (unsigned)kpa * 1536u + klane, ob = (unsigned)kpb * 1536u + klane; \
        ka0 = *(const bf16x8*)(kb + oa); ka1 = *(const bf16x8*)(kb + oa + 64); kb0 = *(const bf16x8*)(kb + ob); kb1 = *(const bf16x8*)(kb + ob + 64); \
        const int p0 = min(max(t0 + d * ((r0) + (lane >> 3)), 0), SEQ - 1), p1 = min(max(t0 + d * ((r0) + 8 + (lane >> 3)), 0), SEQ - 1); \
        const int p2 = min(max(t0 + d * ((r0) + 16 + (lane >> 3)), 0), SEQ - 1), p3 = min(max(t0 + d * ((r0) + 24 + (lane >> 3)), 0), SEQ - 1); \
        v0 = *(const u32x4*)(vb + (unsigned)p0 * 1536u + vlane); v1 = *(const u32x4*)(vb + (unsigned)p1 * 1536u + vlane); \
        v2 = *(const u32x4*)(vb + (unsigned)p2 * 1536u + vlane); v3 = *(const u32x4*)(vb + (unsigned)p3 * 1536u + vlane); } while (0)
        MIXB_LOAD(-128);
#pragma nounroll
        for (int tp = 0; tp < NP; ++tp) {
            *(LAS u32x4*)(wl + (lane >> 3) * VST + (lane & 7) * 16) = v0; *(LAS u32x4*)(wl + (8 + (lane >> 3)) * VST + (lane & 7) * 16) = v1;
            *(LAS u32x4*)(wl + (16 + (lane >> 3)) * VST + (lane & 7) * 16) = v2; *(LAS u32x4*)(wl + (24 + (lane >> 3)) * VST + (lane & 7) * 16) = v3;
            f32x4 sa = (f32x4){0.f, 0.f, 0.f, 0.f}, sb = (f32x4){0.f, 0.f, 0.f, 0.f};
            sa = __builtin_amdgcn_mfma_f32_16x16x32_bf16(ka0, q0, sa, 0, 0, 0); sb = __builtin_amdgcn_mfma_f32_16x16x32_bf16(kb0, q0, sb, 0, 0, 0);
            sa = __builtin_amdgcn_mfma_f32_16x16x32_bf16(ka1, q1, sa, 0, 0, 0); sb = __builtin_amdgcn_mfma_f32_16x16x32_bf16(kb1, q1, sb, 0, 0, 0);
            { const int rn = -128 + 32 * min(tp + 1, NP - 1); MIXB_LOAD(rn); }
            const int relk0 = -128 + 32 * tp + 4 * fq;
            float sv[8] = {sa.x, sa.y, sa.z, sa.w, sb.x, sb.y, sb.z, sb.w};
#pragma unroll
            for (int jj = 0; jj < 8; ++jj) { const int relk = relk0 + (jj & 3) + 16 * (jj >> 2), dlt = relq - relk; const bool ok = dlt >= 0 && dlt <= 128 && (t0 + d * relk) >= 0; sv[jj] = ok ? sv[jj] : -INFINITY; }
            float tmax = fmaxf(fmaxf(fmaxf(sv[0], sv[1]), fmaxf(sv[2], sv[3])), fmaxf(fmaxf(sv[4], sv[5]), fmaxf(sv[6], sv[7])));
            { const auto r = __builtin_amdgcn_permlane16_swap(__float_as_uint(tmax), __float_as_uint(tmax), false, false); tmax = fmaxf(__uint_as_float(r[0]), __uint_as_float(r[1]));
              const auto q = __builtin_amdgcn_permlane32_swap(__float_as_uint(tmax), __float_as_uint(tmax), false, false); tmax = fmaxf(__uint_as_float(q[0]), __uint_as_float(q[1])); }
            const float mn = fmaxf(m, tmax), mu = mn == -INFINITY ? 0.f : mn;
            const float alpha = __expf(m - mu);
            float p[8];
#pragma unroll
            for (int jj = 0; jj < 8; ++jj) p[jj] = __expf(sv[jj] - mu);
            lsum = lsum * alpha + (((p[0] + p[1]) + (p[2] + p[3])) + ((p[4] + p[5]) + (p[6] + p[7])));
            m = mn;
#pragma unroll
            for (int cc = 0; cc < 4; ++cc) O[cc] = O[cc] * alpha;
            u32x4 pw; pw.x = cvt_pk_bf16(p[0], p[1]); pw.y = cvt_pk_bf16(p[2], p[3]); pw.z = cvt_pk_bf16(p[4], p[5]); pw.w = cvt_pk_bf16(p[6], p[7]);
            const bf16x8 pb = __builtin_bit_cast(bf16x8, pw);
            u32x2 a0, a1, a2, a3, b0, b1, b2, b3;
            asm volatile("s_waitcnt lgkmcnt(0)\n\tds_read_b64_tr_b16 %0, %8\n\tds_read_b64_tr_b16 %1, %8 offset:32\n\tds_read_b64_tr_b16 %2, %8 offset:64\n\tds_read_b64_tr_b16 %3, %8 offset:96\n\t"
                         "ds_read_b64_tr_b16 %4, %8 offset:2304\n\tds_read_b64_tr_b16 %5, %8 offset:2336\n\tds_read_b64_tr_b16 %6, %8 offset:2368\n\tds_read_b64_tr_b16 %7, %8 offset:2400\n\ts_waitcnt lgkmcnt(0)"
                         : "=&v"(a0), "=&v"(a1), "=&v"(a2), "=&v"(a3), "=&v"(b0), "=&v"(b1), "=&v"(b2), "=&v"(b3) : "v"(tr_base) : "memory");
#define MIXB_PV(c, AA, BB) { u32x4 vv; vv.x = AA.x; vv.y = AA.y; vv.z = BB.x; vv.w = BB.y; O[c] = __builtin_amdgcn_mfma_f32_16x16x32_bf16(__builtin_bit_cast(bf16x8, vv), pb, O[c], 0, 0, 0); }
            MIXB_PV(0, a0, b0) MIXB_PV(1, a1, b1) MIXB_PV(2, a2, b2) MIXB_PV(3, a3, b3)
#undef MIXB_PV
        }
#undef MIXB_LOAD
    }
    float lt = lsum; lt += __shfl_xor(lt, 16); lt += __shfl_xor(lt, 32);
    const float inv = 1.f / lt;
    bf16* op = P.AB + (rowb + tq) * 768 + 512 + j * 64 + 4 * fq;
#pragma unroll
    for (int cc = 0; cc < 4; ++cc) st4(op + 16 * cc, O[cc] * inv);
}

constexpr int MIX_WAVE_LDS = 20224;
constexpr int CAP = 1280;
constexpr int MA_AVAL = 0, MA_AIDX = 5120, MA_BVAL = 7680, MA_BIDX = 12800, MA_HIST = 15360, MA_SIDE = 16384, MA_LIST = 19200;
constexpr int MA_TILE = 0, MA_TILEB = 9216;
__device__ __forceinline__ unsigned f2u(float f) { const unsigned b = __float_as_uint(f); return b ^ ((b >> 31) ? 0xFFFFFFFFu : 0x80000000u); }
__device__ __forceinline__ float u2f(unsigned u) { const unsigned b = (u >> 31) ? (u ^ 0x80000000u) : ~u; return __uint_as_float(b); }
__device__ __forceinline__ unsigned wave_umax(unsigned v) {
#pragma unroll
    for (int o = 1; o < 64; o <<= 1) { const unsigned w = (unsigned)__shfl_xor((int)v, o); v = v > w ? v : w; }
    return v;
}
__device__ __forceinline__ float wave_max(float v) {
#pragma unroll
    for (int o = 1; o < 64; o <<= 1) v = fmaxf(v, __shfl_xor(v, o));
    return v;
}
__device__ __forceinline__ void hist_find(const LAS unsigned* hist, int need, int lane, int& bstar, int& above_out) {
    const u32x4 c = *(const LAS u32x4*)(hist + 4 * lane);
    const int s = (int)(c.x + c.y + c.z + c.w); int pre = s;
    pre += __builtin_amdgcn_update_dpp(0, pre, 0x111, 0xf, 0xf, true);
    pre += __builtin_amdgcn_update_dpp(0, pre, 0x112, 0xf, 0xf, true);
    pre += __builtin_amdgcn_update_dpp(0, pre, 0x114, 0xf, 0xf, true);
    pre += __builtin_amdgcn_update_dpp(0, pre, 0x118, 0xf, 0xf, true);
    const int R0 = __builtin_amdgcn_readlane(pre, 15), R1 = __builtin_amdgcn_readlane(pre, 31), R2 = __builtin_amdgcn_readlane(pre, 47), R3 = __builtin_amdgcn_readlane(pre, 63);
    const int row = lane >> 4; const int gpre = pre + (row >= 1 ? R0 : 0) + (row >= 2 ? R1 : 0) + (row >= 3 ? R2 : 0);
    const int above = (R0 + R1 + R2 + R3) - gpre, t = above + s;
    const bool hit = above < need && need <= t;
    const unsigned long long hm = __ballot(hit);
    const int L = hm ? (int)__builtin_ctzll(hm) : 0;
    int digit, cum = above;
    if (cum + (int)c.w >= need) digit = 3; else { cum += (int)c.w; if (cum + (int)c.z >= need) digit = 2; else { cum += (int)c.z; if (cum + (int)c.y >= need) digit = 1; else { cum += (int)c.y; digit = 0; } } }
    digit += 4 * lane;
    bstar = __builtin_amdgcn_readlane(digit, L); above_out = __builtin_amdgcn_readlane(cum, L);
}
__device__ __forceinline__ unsigned compact256(LAS unsigned* val, LAS unsigned short* idx, LAS unsigned* hist, int n, int lane) {
    unsigned prefix = 0u; int kk = 256;
    const int nch = (n + 63) >> 6;
    const unsigned long long ltm = (1ull << lane) - 1ull;
#pragma nounroll
    for (int pass = 0; pass < 4; ++pass) {
        const int shift = 24 - 8 * pass;
        *(LAS u32x4*)(hist + 4 * lane) = (u32x4){0u, 0u, 0u, 0u};
        LDS_WAIT();
#pragma nounroll
        for (int mc = 0; mc < nch; ++mc) { const int i = lane + 64 * mc;
            if (i < n) { const unsigned u = val[i]; const bool in = ((unsigned long long)u >> (shift + 8)) == (unsigned long long)prefix;
                if (in) __hip_atomic_fetch_add(&hist[(u >> shift) & 255u], 1u, __ATOMIC_RELAXED, __HIP_MEMORY_SCOPE_WAVEFRONT); } }
        LDS_WAIT();
        int digit, cum; hist_find(hist, kk, lane, digit, cum);
        kk -= cum; prefix = (prefix << 8) | (unsigned)digit;
    }
    const unsigned T = prefix; int outp = 0, eqc = 0;
#pragma nounroll
    for (int mc = 0; mc < nch; ++mc) { const int i = lane + 64 * mc; const bool in = i < n;
        const unsigned u = in ? val[i] : 0u; const unsigned short id = in ? idx[i] : (unsigned short)0;
        const bool gt = in && u > T, eq = in && u == T;
        const unsigned long long eqm = __ballot(eq);
        const bool keep = gt || (eq && (eqc + (int)__popcll(eqm & ltm)) < kk);
        const unsigned long long km = __ballot(keep);
        const int dst = outp + (int)__popcll(km & ltm);
        if (keep) { val[dst] = u; idx[dst] = id; }
        outp += (int)__popcll(km); eqc += (int)__popcll(eqm); }
    LDS_WAIT();
    return T;
}
__device__ __forceinline__ int compact_approx(LAS unsigned* val, LAS unsigned short* idx, LAS unsigned* hist, int n, unsigned& edge_u, unsigned umax, int lane) {
    const unsigned range = umax - edge_u;
    const int sh = max(0, 24 - (int)__builtin_clz(range | 1u));
    const int nst = (n + 255) >> 8;
    const unsigned long long ltm = (1ull << lane) - 1ull;
    *(LAS u32x4*)(hist + 4 * lane) = (u32x4){0u, 0u, 0u, 0u};
    LDS_WAIT();
#pragma nounroll
    for (int st = 0; st < nst; ++st) { const int i0 = 256 * st + lane; unsigned u[4];
#pragma unroll
        for (int c = 0; c < 4; ++c) u[c] = (i0 + 64 * c) < n ? val[i0 + 64 * c] : 0u;
#pragma unroll
        for (int c = 0; c < 4; ++c) if ((i0 + 64 * c) < n) __hip_atomic_fetch_add(&hist[min((u[c] - edge_u) >> sh, 255u)], 1u, __ATOMIC_RELAXED, __HIP_MEMORY_SCOPE_WAVEFRONT); }
    LDS_WAIT();
    int b, above; hist_find(hist, 256, lane, b, above);
    const unsigned E = edge_u + ((unsigned)b << sh);
    int outp = 0;
#pragma nounroll
    for (int st = 0; st < nst; ++st) { const int i0 = 256 * st + lane; unsigned u[4]; unsigned short id[4]; unsigned long long km[4];
#pragma unroll
        for (int c = 0; c < 4; ++c) { const bool in = (i0 + 64 * c) < n; u[c] = in ? val[i0 + 64 * c] : 0u; id[c] = in ? idx[i0 + 64 * c] : (unsigned short)0; }
#pragma unroll
        for (int c = 0; c < 4; ++c) km[c] = __builtin_amdgcn_ballot_w64((i0 + 64 * c) < n && u[c] >= E);
#pragma unroll
        for (int c = 0; c < 4; ++c) { const bool keep = (i0 + 64 * c) < n && u[c] >= E; const int dst = outp + (int)__popcll(km[c] & ltm);
            if (keep) { val[dst] = u[c]; idx[dst] = id[c]; }
            outp += (int)__popcll(km[c]); } }
    LDS_WAIT();
    edge_u = E - 1u;
    return outp;
}
__device__ __forceinline__ int select_final(LAS unsigned* val, LAS unsigned short* idx, LAS unsigned* hist, LAS unsigned* side, LAS unsigned short* list, int n, unsigned edge_u, unsigned umax, int lane) {
    if (n <= 256) { for (int i = lane; i < n; i += 64) list[i] = idx[i]; LDS_WAIT(); return n; }
    const unsigned range = umax - edge_u;
    const int sh = max(0, 24 - (int)__builtin_clz(range | 1u));
    const int nst = (n + 255) >> 8;
    const unsigned long long ltm = (1ull << lane) - 1ull;
    *(LAS u32x4*)(hist + 4 * lane) = (u32x4){0u, 0u, 0u, 0u};
    LDS_WAIT();
#pragma nounroll
    for (int st = 0; st < nst; ++st) { const int i0 = 256 * st + lane; unsigned u[4];
#pragma unroll
        for (int c = 0; c < 4; ++c) u[c] = (i0 + 64 * c) < n ? val[i0 + 64 * c] : 0u;
#pragma unroll
        for (int c = 0; c < 4; ++c) if ((i0 + 64 * c) < n) __hip_atomic_fetch_add(&hist[min((u[c] - edge_u) >> sh, 255u)], 1u, __ATOMIC_RELAXED, __HIP_MEMORY_SCOPE_WAVEFRONT); }
    LDS_WAIT();
    int b, above; hist_find(hist, 256, lane, b, above);
    const int cb = __builtin_amdgcn_readfirstlane((int)hist[b]);
    if (cb > 64) { (void)compact256(val, idx, hist, n, lane); for (int i = lane; i < 256; i += 64) list[i] = idx[i]; LDS_WAIT(); return 256; }
    const int kk = 256 - above;
    int outp = 0, sc = 0;
#pragma nounroll
    for (int st = 0; st < nst; ++st) { const int i0 = 256 * st + lane; unsigned u[4]; unsigned short id[4]; unsigned long long km[4], em[4];
#pragma unroll
        for (int c = 0; c < 4; ++c) { const bool in = (i0 + 64 * c) < n; u[c] = in ? val[i0 + 64 * c] : 0u; id[c] = in ? idx[i0 + 64 * c] : (unsigned short)0; }
#pragma unroll
        for (int c = 0; c < 4; ++c) { const bool in = (i0 + 64 * c) < n; const int bin = (int)min((u[c] - edge_u) >> sh, 255u); km[c] = __builtin_amdgcn_ballot_w64(in && bin > b); em[c] = __builtin_amdgcn_ballot_w64(in && bin == b); }
#pragma unroll
        for (int c = 0; c < 4; ++c) { const bool in = (i0 + 64 * c) < n; const int bin = (int)min((u[c] - edge_u) >> sh, 255u);
            if (in && bin > b) list[outp + (int)__popcll(km[c] & ltm)] = id[c];
            if (in && bin == b) { const int j = sc + (int)__popcll(em[c] & ltm); side[j] = u[c]; side[64 + j] = (unsigned)id[c]; }
            outp += (int)__popcll(km[c]); sc += (int)__popcll(em[c]); } }
    LDS_WAIT();
    bool keep = false; unsigned myid = 0u;
    if (lane < cb) { const unsigned u = side[lane]; myid = side[64 + lane]; int rank = 0;
        for (int j = 0; j < cb; ++j) { const unsigned uj = side[j]; rank += (uj > u || (uj == u && j < lane)) ? 1 : 0; }
        keep = rank < kk; }
    const unsigned long long km = __ballot(keep);
    if (keep) list[outp + (int)__popcll(km & ltm)] = (unsigned short)myid;
    LDS_WAIT();
    return 256;
}

__device__ __forceinline__ void mixa_dma(const Ptrs& P, LAS unsigned char* tb, size_t rowb, const LAS unsigned short* list, int nsel, int tile, int lane) {
    const int gr = lane >> 2, gp4 = lane & 3;
    const int ki = 16 * tile + gr; const int key = ki < nsel ? (int)list[ki] : 0; const char* src = (const char*)(P.KV + (rowb + key) * KVS) + gp4 * 16;
#pragma unroll
    for (int i = 0; i < 9; ++i) __builtin_amdgcn_global_load_lds((const unsigned*)(src + 64 * i), (LAS unsigned*)(tb + 1024 * i), 16, 0, 0);
}
__device__ __forceinline__ void mixa_step(const Ptrs& P, LAS unsigned char* tb, LAS unsigned char* tnext, size_t rowb, const LAS unsigned short* list, int nsel, int tile, int ntile, int lane,
                                          const bf16x8 (&qf)[8], const bf16x8 qr, float& m, float& lsum, f32x4 (&O)[16]) {
    const int fr = lane & 15, fq = lane >> 4;
    const bf16x8 zero8 = (bf16x8){0, 0, 0, 0, 0, 0, 0, 0};
    asm volatile("s_waitcnt vmcnt(0)" ::: "memory");
    mixa_dma(P, tnext, rowb, list, nsel, min(tile + 1, ntile - 1), lane);
    f32x4 zc0 = (f32x4){0.f, 0.f, 0.f, 0.f}, zc1 = (f32x4){0.f, 0.f, 0.f, 0.f}, zr = (f32x4){0.f, 0.f, 0.f, 0.f};
    const LAS unsigned char* ta = tb + fr * 64 + 16 * fq;
#pragma unroll
    for (int s = 0; s < 8; s += 2) {
        zc0 = __builtin_amdgcn_mfma_f32_16x16x32_bf16(*(const LAS bf16x8*)(ta + 1024 * s), qf[s], zc0, 0, 0, 0);
        zc1 = __builtin_amdgcn_mfma_f32_16x16x32_bf16(*(const LAS bf16x8*)(ta + 1024 * s + 1024), qf[s + 1], zc1, 0, 0, 0); }
    { bf16x8 a = *(const LAS bf16x8*)(tb + 8192 + fr * 64 + 16 * (fq & 1)); a = fq < 2 ? a : zero8; zr = __builtin_amdgcn_mfma_f32_16x16x32_bf16(a, qr, zr, 0, 0, 0); }
    const float zcv[4] = {zc0.x + zc1.x, zc0.y + zc1.y, zc0.z + zc1.z, zc0.w + zc1.w}, zrv[4] = {zr.x, zr.y, zr.z, zr.w};
    float sv[4];
#pragma unroll
    for (int jj = 0; jj < 4; ++jj) { const bool ok = (16 * tile + 4 * fq + jj) < nsel; sv[jj] = ok ? zcv[jj] + zrv[jj] : -INFINITY; }
    float tmax = fmaxf(fmaxf(sv[0], sv[1]), fmaxf(sv[2], sv[3]));
    { const auto r = __builtin_amdgcn_permlane16_swap(__float_as_uint(tmax), __float_as_uint(tmax), false, false); tmax = fmaxf(__uint_as_float(r[0]), __uint_as_float(r[1]));
      const auto q = __builtin_amdgcn_permlane32_swap(__float_as_uint(tmax), __float_as_uint(tmax), false, false); tmax = fmaxf(__uint_as_float(q[0]), __uint_as_float(q[1])); }
    if (__ballot(tmax > m + 16.f)) {
        const float mn = tmax > m + 16.f ? tmax : m;
        const float alpha = m == -INFINITY ? 0.f : __expf(m - mn);
        lsum *= alpha; m = mn;
#pragma unroll
        for (int c = 0; c < 16; ++c) O[c] = O[c] * alpha; }
    float p[4];
#pragma unroll
    for (int jj = 0; jj < 4; ++jj) p[jj] = __expf(sv[jj] - m);
    lsum += (p[0] + p[1]) + (p[2] + p[3]);
    u32x2 pw; pw.x = cvt_pk_bf16(p[0], p[1]); pw.y = cvt_pk_bf16(p[2], p[3]);
    const bf16x4 pb = __builtin_bit_cast(bf16x4, pw);
    const unsigned tr_base = (unsigned)(size_t)tb + (unsigned)((4 * fq + (fr >> 2)) * 64 + (fr & 3) * 8);
#pragma unroll
    for (int c8 = 0; c8 < 2; ++c8) {
        u32x2 t0, t1, t2, t3, t4, t5, t6, t7;
        asm volatile("s_waitcnt lgkmcnt(0)\n\tds_read_b64_tr_b16 %0, %8 offset:%9\n\tds_read_b64_tr_b16 %1, %8 offset:%10\n\tds_read_b64_tr_b16 %2, %8 offset:%11\n\tds_read_b64_tr_b16 %3, %8 offset:%12\n\t"
                     "ds_read_b64_tr_b16 %4, %8 offset:%13\n\tds_read_b64_tr_b16 %5, %8 offset:%14\n\tds_read_b64_tr_b16 %6, %8 offset:%15\n\tds_read_b64_tr_b16 %7, %8 offset:%16\n\ts_waitcnt lgkmcnt(0)"
                     : "=&v"(t0), "=&v"(t1), "=&v"(t2), "=&v"(t3), "=&v"(t4), "=&v"(t5), "=&v"(t6), "=&v"(t7)
                     : "v"(tr_base), "n"(4096 * c8), "n"(4096 * c8 + 32), "n"(4096 * c8 + 1024), "n"(4096 * c8 + 1056), "n"(4096 * c8 + 2048), "n"(4096 * c8 + 2080), "n"(4096 * c8 + 3072), "n"(4096 * c8 + 3104) : "memory");
        O[8 * c8 + 0] = __builtin_amdgcn_mfma_f32_16x16x16bf16_1k(__builtin_bit_cast(bf16x4, t0), pb, O[8 * c8 + 0], 0, 0, 0);
        O[8 * c8 + 1] = __builtin_amdgcn_mfma_f32_16x16x16bf16_1k(__builtin_bit_cast(bf16x4, t1), pb, O[8 * c8 + 1], 0, 0, 0);
        O[8 * c8 + 2] = __builtin_amdgcn_mfma_f32_16x16x16bf16_1k(__builtin_bit_cast(bf16x4, t2), pb, O[8 * c8 + 2], 0, 0, 0);
        O[8 * c8 + 3] = __builtin_amdgcn_mfma_f32_16x16x16bf16_1k(__builtin_bit_cast(bf16x4, t3), pb, O[8 * c8 + 3], 0, 0, 0);
        O[8 * c8 + 4] = __builtin_amdgcn_mfma_f32_16x16x16bf16_1k(__builtin_bit_cast(bf16x4, t4), pb, O[8 * c8 + 4], 0, 0, 0);
        O[8 * c8 + 5] = __builtin_amdgcn_mfma_f32_16x16x16bf16_1k(__builtin_bit_cast(bf16x4, t5), pb, O[8 * c8 + 5], 0, 0, 0);
        O[8 * c8 + 6] = __builtin_amdgcn_mfma_f32_16x16x16bf16_1k(__builtin_bit_cast(bf16x4, t6), pb, O[8 * c8 + 6], 0, 0, 0);
        O[8 * c8 + 7] = __builtin_amdgcn_mfma_f32_16x16x16bf16_1k(__builtin_bit_cast(bf16x4, t7), pb, O[8 * c8 + 7], 0, 0, 0);
    }
}
__device__ __forceinline__ void mixa_attend(const Ptrs& P, LAS unsigned char* wl, size_t row, size_t rowb, const LAS unsigned short* list, int nsel, int lane) {
    const int fr = lane & 15, fq = lane >> 4;
    const bf16x8 zero8 = (bf16x8){0, 0, 0, 0, 0, 0, 0, 0};
    const int ntile = (nsel + 15) >> 4;
    mixa_dma(P, wl + MA_TILE, rowb, list, nsel, 0, lane);
    bf16x8 qf[8], qr;
#pragma unroll
    for (int s = 0; s < 8; ++s) qf[s] = fr < 8 ? *(const bf16x8*)(P.QL + row * 2048 + fr * 256 + 32 * s + 8 * fq) : zero8;
    qr = (fr < 8 && fq < 2) ? *(const bf16x8*)(P.AQ + row * 512 + fr * 64 + 8 * fq) : zero8;
    float m = -INFINITY, lsum = 0.f;
    f32x4 O[16];
#pragma unroll
    for (int c = 0; c < 16; ++c) O[c] = (f32x4){0.f, 0.f, 0.f, 0.f};
#pragma nounroll
    for (int tile = 0; tile < ntile; tile += 2) {
        mixa_step(P, wl + MA_TILE, wl + MA_TILEB, rowb, list, nsel, tile, ntile, lane, qf, qr, m, lsum, O);
        if (tile + 1 < ntile) mixa_step(P, wl + MA_TILEB, wl + MA_TILE, rowb, list, nsel, tile + 1, ntile, lane, qf, qr, m, lsum, O);
    }
    asm volatile("s_waitcnt vmcnt(0)" ::: "memory");
    float lt = lsum; lt += __shfl_xor(lt, 16); lt += __shfl_xor(lt, 32);
    const float inv = 1.f / lt;
    if (fr < 8) {
#pragma unroll
        for (int c = 0; c < 16; ++c) { const f32x4 v = O[c] * inv; u32x2 w; w.x = cvt_pk_bf16(v.x, v.y); w.y = cvt_pk_bf16(v.z, v.w); *(LAS u32x2*)(wl + MA_TILE + fr * 512 + (16 * c + 4 * fq) * 2) = w; } }
    LDS_WAIT();
#pragma unroll
    for (int i = 0; i < 4; ++i) { const int h = 2 * i + (lane >> 5); const u32x4 o = *(const LAS u32x4*)(wl + MA_TILE + h * 512 + (lane & 31) * 16); *(u32x4*)(P.OL + row * 2048 + h * 256 + (lane & 31) * 8) = o; }
    LDS_WAIT();
}

#define IDX_GROUP(ca, cb, cc, cd, s01, s23) do { \
        const f32x4 za = __builtin_amdgcn_mfma_f32_16x16x32_bf16(xq, ca, z4, 0, 0, 0), zb = __builtin_amdgcn_mfma_f32_16x16x32_bf16(xq, cb, z4, 0, 0, 0); \
        const f32x4 zc = __builtin_amdgcn_mfma_f32_16x16x32_bf16(xq, cc, z4, 0, 0, 0), zd = __builtin_amdgcn_mfma_f32_16x16x32_bf16(xq, cd, z4, 0, 0, 0); \
        const f32x4 la = __builtin_amdgcn_mfma_f32_16x16x32_bf16(xl, ca, z4, 0, 0, 0), lb = __builtin_amdgcn_mfma_f32_16x16x32_bf16(xl, cb, z4, 0, 0, 0); \
        const f32x4 lc = __builtin_amdgcn_mfma_f32_16x16x32_bf16(xl, cc, z4, 0, 0, 0), ld = __builtin_amdgcn_mfma_f32_16x16x32_bf16(xl, cd, z4, 0, 0, 0); \
        const float pa = fmaf(hw.w, fabsf(za.w), fmaf(hw.z, fabsf(za.z), fmaf(hw.y, fabsf(za.y), fmaf(hw.x, fabsf(za.x), la.x)))); \
        const float pb = fmaf(hw.w, fabsf(zb.w), fmaf(hw.z, fabsf(zb.z), fmaf(hw.y, fabsf(zb.y), fmaf(hw.x, fabsf(zb.x), lb.x)))); \
        const float pc = fmaf(hw.w, fabsf(zc.w), fmaf(hw.z, fabsf(zc.z), fmaf(hw.y, fabsf(zc.y), fmaf(hw.x, fabsf(zc.x), lc.x)))); \
        const float pd = fmaf(hw.w, fabsf(zd.w), fmaf(hw.z, fabsf(zd.z), fmaf(hw.y, fabsf(zd.y), fmaf(hw.x, fabsf(zd.x), ld.x)))); \
        const auto r01 = __builtin_amdgcn_permlane16_swap(__float_as_uint(pa), __float_as_uint(pb), false, false); \
        const auto r23 = __builtin_amdgcn_permlane16_swap(__float_as_uint(pc), __float_as_uint(pd), false, false); \
        s01 = (__uint_as_float(r01[0]) + __uint_as_float(r01[1])) + 0.f; s23 = (__uint_as_float(r23[0]) + __uint_as_float(r23[1])) + 0.f; } while (0)
__device__ __forceinline__ void mixa_pair(const Ptrs& P, LAS unsigned char* wl, int b, int pp, int lane) {
    const int fr = lane & 15, fq = lane >> 4, half = fq >> 1; const size_t rowb = (size_t)b * SEQ; const int tA = 2 * pp;
    LAS unsigned* aval = (LAS unsigned*)(wl + MA_AVAL); LAS unsigned short* aidx = (LAS unsigned short*)(wl + MA_AIDX);
    LAS unsigned* bval = (LAS unsigned*)(wl + MA_BVAL); LAS unsigned short* bidx = (LAS unsigned short*)(wl + MA_BIDX); LAS unsigned* hist = (LAS unsigned*)(wl + MA_HIST);
    LAS unsigned* side = (LAS unsigned*)(wl + MA_SIDE);
    const bf16x8 xq = *(const bf16x8*)(P.IQ + (rowb + tA + (fr >> 3)) * 256 + (fr & 7) * 32 + 8 * fq);
    const f32x4 wv = *(const f32x4*)(P.IW + (rowb + tA + half) * 8 + 4 * (fq & 1));
    const f32x4 hw = wv * 0.5f;
    bf16x8 xl;
    { const size_t qrow = rowb + tA + (fr >> 3); const f32x4 w0 = *(const f32x4*)(P.IW + qrow * 8), w1 = *(const f32x4*)(P.IW + qrow * 8 + 4);
      const float wh[8] = {w0.x, w0.y, w0.z, w0.w, w1.x, w1.y, w1.z, w1.w}; float lv[8] = {0.f, 0.f, 0.f, 0.f, 0.f, 0.f, 0.f, 0.f};
#pragma unroll
      for (int h = 0; h < 8; ++h) { const u32x4 q4 = *(const u32x4*)(P.IQ + qrow * 256 + h * 32 + 8 * fq); const unsigned qq[4] = {q4.x, q4.y, q4.z, q4.w};
#pragma unroll
          for (int e = 0; e < 4; ++e) { lv[2 * e] = fmaf(wh[h], __uint_as_float(qq[e] << 16), lv[2 * e]); lv[2 * e + 1] = fmaf(wh[h], __uint_as_float(qq[e] & 0xffff0000u), lv[2 * e + 1]); } }
      u32x4 pk; pk.x = cvt_pk_bf16(lv[0] * 0.25f, lv[1] * 0.25f); pk.y = cvt_pk_bf16(lv[2] * 0.25f, lv[3] * 0.25f); pk.z = cvt_pk_bf16(lv[4] * 0.25f, lv[5] * 0.25f); pk.w = cvt_pk_bf16(lv[6] * 0.25f, lv[7] * 0.25f);
      xl = __builtin_bit_cast(bf16x8, pk); }
    const int tq = tA + half;
    unsigned edgeA = f2u(-INFINITY), edgeB = edgeA; float tauA = -INFINITY, tauB = -INFINITY; int cntA = 0, cntB = 0;
    unsigned umx = f2u(-INFINITY);
    const int ntile = ((tA + 1) >> 4) + 1, niter = (ntile + 7) >> 3;
    const bf16* ikp = P.IK + (rowb + fr) * 32 + 8 * fq;
    const unsigned lt32 = (1u << (lane & 31)) - 1u;
    bf16x8 y0 = *(const bf16x8*)ikp, y1 = *(const bf16x8*)(ikp + 512), y2 = *(const bf16x8*)(ikp + 1024), y3 = *(const bf16x8*)(ikp + 1536);
    bf16x8 y4 = *(const bf16x8*)(ikp + 2048), y5 = *(const bf16x8*)(ikp + 2560), y6 = *(const bf16x8*)(ikp + 3072), y7 = *(const bf16x8*)(ikp + 3584);
    const f32x4 z4 = (f32x4){0.f, 0.f, 0.f, 0.f};
#pragma nounroll
    for (int it = 0; it < niter; ++it) {
        const bf16* np = ikp + (size_t)min(it + 1, niter - 1) * 4096;
        float s0, s1, s2, s3;
        IDX_GROUP(y0, y1, y2, y3, s0, s1);
        y0 = *(const bf16x8*)np; y1 = *(const bf16x8*)(np + 512); y2 = *(const bf16x8*)(np + 1024); y3 = *(const bf16x8*)(np + 1536);
        IDX_GROUP(y4, y5, y6, y7, s2, s3);
        y4 = *(const bf16x8*)(np + 2048); y5 = *(const bf16x8*)(np + 2560); y6 = *(const bf16x8*)(np + 3072); y7 = *(const bf16x8*)(np + 3584);
        const int k0 = 128 * it + 16 * (fq & 1) + fr;
        const float tau = half ? tauB : tauA;
        const bool d0 = k0 <= tq && s0 > tau, d1 = k0 + 32 <= tq && s1 > tau, d2 = k0 + 64 <= tq && s2 > tau, d3 = k0 + 96 <= tq && s3 > tau;
        const unsigned long long m0 = __builtin_amdgcn_ballot_w64(k0 <= tq) & __builtin_amdgcn_ballot_w64(s0 > tau), m1 = __builtin_amdgcn_ballot_w64(k0 + 32 <= tq) & __builtin_amdgcn_ballot_w64(s1 > tau);
        const unsigned long long m2 = __builtin_amdgcn_ballot_w64(k0 + 64 <= tq) & __builtin_amdgcn_ballot_w64(s2 > tau), m3 = __builtin_amdgcn_ballot_w64(k0 + 96 <= tq) & __builtin_amdgcn_ballot_w64(s3 > tau);
        if ((m0 | m1) | (m2 | m3)) {
            const unsigned h0 = half ? (unsigned)(m0 >> 32) : (unsigned)m0, h1 = half ? (unsigned)(m1 >> 32) : (unsigned)m1, h2 = half ? (unsigned)(m2 >> 32) : (unsigned)m2, h3 = half ? (unsigned)(m3 >> 32) : (unsigned)m3;
            const int base = half ? cntB : cntA;
            const int p0 = base + __popc(h0 & lt32), p1 = base + __popc(h0) + __popc(h1 & lt32), p2 = base + __popc(h0) + __popc(h1) + __popc(h2 & lt32), p3 = base + __popc(h0) + __popc(h1) + __popc(h2) + __popc(h3 & lt32);
            LAS unsigned* v = half ? bval : aval; LAS unsigned short* ix = half ? bidx : aidx;
            if (d0) { const unsigned u_ = f2u(s0); v[p0] = u_; ix[p0] = (unsigned short)k0; umx = umx > u_ ? umx : u_; }
            if (d1) { const unsigned u_ = f2u(s1); v[p1] = u_; ix[p1] = (unsigned short)(k0 + 32); umx = umx > u_ ? umx : u_; }
            if (d2) { const unsigned u_ = f2u(s2); v[p2] = u_; ix[p2] = (unsigned short)(k0 + 64); umx = umx > u_ ? umx : u_; }
            if (d3) { const unsigned u_ = f2u(s3); v[p3] = u_; ix[p3] = (unsigned short)(k0 + 96); umx = umx > u_ ? umx : u_; }
            cntA += (__popc((unsigned)m0) + __popc((unsigned)m1)) + (__popc((unsigned)m2) + __popc((unsigned)m3));
            cntB += (__popc((unsigned)(m0 >> 32)) + __popc((unsigned)(m1 >> 32))) + (__popc((unsigned)(m2 >> 32)) + __popc((unsigned)(m3 >> 32)));
            if (cntA > CAP - 128 || cntB > CAP - 128) {
#pragma nounroll
                for (int qq = 0; qq < 2; ++qq) { const int cq = qq ? cntB : cntA;
                    if (cq > CAP - 128) { LDS_WAIT(); const unsigned umax = wave_umax((half == qq) ? umx : f2u(-INFINITY)); unsigned eq = qq ? edgeB : edgeA;
                        LAS unsigned* cv = qq ? bval : aval; LAS unsigned short* ci = qq ? bidx : aidx;
                        int n2 = compact_approx(cv, ci, hist, cq, eq, umax, lane);
                        if (n2 > CAP - 256) { eq = compact256(cv, ci, hist, n2, lane); n2 = 256; }
                        if (qq) { cntB = n2; edgeB = eq; tauB = u2f(eq); } else { cntA = n2; edgeA = eq; tauA = u2f(eq); } } } }
        }
    }
    LDS_WAIT();
    LAS unsigned short* listA = (LAS unsigned short*)(wl + MA_LIST); LAS unsigned short* listB = listA + 256;
    const unsigned umaxA = wave_umax(half ? f2u(-INFINITY) : umx), umaxB = wave_umax(half ? umx : f2u(-INFINITY));
    int nA = 0, nB = 0;
#pragma nounroll
    for (int qq = 0; qq < 2; ++qq) { const int n = select_final(qq ? bval : aval, qq ? bidx : aidx, hist, side, qq ? listB : listA, qq ? cntB : cntA, qq ? edgeB : edgeA, qq ? umaxB : umaxA, lane); if (qq) nB = n; else nA = n; }
#pragma nounroll
    for (int qq = 0; qq < 2; ++qq) mixa_attend(P, wl, rowb + tA + qq, rowb, qq ? listB : listA, qq ? nB : nA, lane);
}

__device__ __forceinline__ void mixer_phase(const Ptrs& P, LAS unsigned char* lds, int gw, int NGW, int wave, int lane) {
    LAS unsigned char* wl = lds + wave * MIX_WAVE_LDS;
    if (NGW == 2048) {
        const int b = gw >> 9, r = (gw >> 3) & 63;
#pragma nounroll
        for (int k = 0; k < 8; ++k) { const int g = ((k & 1) ? 63 - r : r) + 64 * k; mixa_pair(P, wl, b, 8 * g + wave, lane); }
    } else {
#pragma nounroll
        for (int pg = gw; pg < NBATCH * 4096; pg += NGW) mixa_pair(P, wl, pg >> 12, pg & 4095, lane);
    }
    { int qb = (gw * (2 * NBATCH) / NGW) & (2 * NBATCH - 1), dry = 0;
#pragma nounroll
      for (;;) { unsigned q = 0u; if (lane == 0) q = __hip_atomic_fetch_add(P.ctl + CW_BQ + 64 * qb, 1u, __ATOMIC_RELAXED, __HIP_MEMORY_SCOPE_AGENT);
          const int it = __builtin_amdgcn_readfirstlane((int)q);
          if (it >= 32 * 16 * 2) { if (++dry == 2 * NBATCH) break; qb = (qb + 1) & (2 * NBATCH - 1); continue; }
          dry = 0;
          const int c = it & 15, j = 2 * (qb & 1) + ((it >> 4) & 1), tb = 31 - (it >> 5); mixb_item(P, wl, qb >> 1, tb, c, j, lane); } }
    if (NGW == 2048) {
        __syncthreads();
        const int b = gw >> 9, r = (gw >> 3) & 63;
        headgemm_wave<256, 64>(P.OL + wave * 256, 2048, P.WV + (size_t)wave * 64 * 256, P.AB + wave * 64, 768, [=](int k) { return b * 512 + ((k & 1) ? 63 - r : r) + 64 * k; }, 8, lane);
    }
}

constexpr int NPHASE = 11;
__global__ void __launch_bounds__(NWAVES * 64, 2) fwd(Args args) {
    extern __shared__ __attribute__((aligned(16))) unsigned char lds_raw[];
    LAS unsigned char* lds = (LAS unsigned char*)lds_raw;
    const int tid = threadIdx.x, lane = tid & 63, wave = __builtin_amdgcn_readfirstlane(tid >> 6);
    const int G = gridDim.x; const int bx = blockIdx.x; const int vcu = (G % 8 == 0) ? (bx % 8) * (G / 8) + bx / 8 : bx;
    const int gw = vcu * NWAVES + wave, NGW = G * NWAVES;
    unsigned char* ws = args.ws;
    Ptrs P;
    P.x = (const float*)args.in[0]; P.positions = (const int*)args.in[1]; P.w_in = (const float*)args.in[2]; P.b_gate = (const float*)args.in[3]; P.g_kv = (const float*)args.in[4];
    P.w_uk = (const float*)args.in[5]; P.w_uv = (const float*)args.in[6]; P.w_ba = (const float*)args.in[7]; P.w_bb = (const float*)args.in[8]; P.w_o = (const float*)args.in[9];
    P.ln1_g = (const float*)args.in[10]; P.ln1_b = (const float*)args.in[11]; P.w_router = (const float*)args.in[12]; P.router_bias = (const float*)args.in[13];
    P.w1_e = (const float*)args.in[14]; P.w3_e = (const float*)args.in[15]; P.w2_e = (const float*)args.in[16]; P.ws1 = (const float*)args.in[17]; P.ws3 = (const float*)args.in[18]; P.ws2 = (const float*)args.in[19];
    P.ln2_g = (const float*)args.in[20]; P.ln2_b = (const float*)args.in[21];
    P.out = args.out; P.ws = ws; P.ctl = (gu32*)(ws + WS_CTL);
    P.XB = (bf16*)(ws + WS_XB); P.WIN = (bf16*)(ws + WS_WIN); P.WAB = (bf16*)(ws + WS_WAB); P.WQ = (bf16*)(ws + WS_WQ); P.WV = (bf16*)(ws + WS_WV); P.WO = (bf16*)(ws + WS_WO); P.AB = (bf16*)((unsigned char*)args.out + 64 * MiB);

    P.QL = (bf16*)(ws + WS_QL); P.KV = (bf16*)(ws + WS_KV); P.IQ = (bf16*)(ws + WS_IQ); P.AQ = (bf16*)(ws + WS_AQ); P.IK = (bf16*)(ws + WS_IK); P.IW = (float*)(ws + WS_IW);
    P.BQ = (bf16*)(ws + WS_BQ); P.BK = (bf16*)(ws + WS_BK); P.BV = (bf16*)(ws + WS_BV); P.OL = (bf16*)(ws + WS_OL);
    P.G = (unsigned char*)args.out; P.MP = (bf16*)(ws + WS_MP); P.HBF = (bf16*)args.out;
    P.W13 = (bf16*)(ws + WS_W13); P.W2 = (bf16*)(ws + WS_W2);
    P.HB = (bf16*)(ws + WS_HB); P.Y = (bf16*)(ws + WS_Y);
    P.R16 = (f32x2*)(ws + WS_R16); P.R8 = (f32x2*)(ws + WS_R8); P.REC = (unsigned*)(ws + WS_REC); P.LIST = (int*)(ws + WS_LIST); P.WLIST = (float*)(ws + WS_WLIST);

    if (tid < 16) ((LAS unsigned*)(lds + LDS_BARW))[tid] = 0u;
    __syncthreads();
    XcdBarrier bar = xcd_barrier_post((unsigned*)(P.ctl + CW_BAR), (volatile LAS unsigned*)(lds + LDS_BARW));
    MoeTab MT; MT.pre = (LAS int*)(lds + 135168); MT.cnt = (LAS int*)(lds + 135168 + 512);

    const int lo = args.ph_lo, hi = args.ph_hi;
#ifndef ONLYPH
#define ONLYPH -1
#endif
#define IN(k) ((ONLYPH < 0 || ONLYPH == (k)) && lo <= (k) && (k) < hi)
#define SEAM(k) do { if (IN(k) && IN((k) + 1)) xcd_barrier(bar); } while (0)

    if (IN(0)) { p0_phase(P, lds, gw, NGW, wave, lane); } SEAM(0);
    if (IN(1)) { gp::DenseOrder S; S.init(P.XB, P.WIN, DM * 2, DM * 2, NTOK, NINP, G, bx); EpiP1 E; E.P = P;
        gp::gemm_phase<EpiP1, gp::DenseOrder, false>(lds, DM, DM * 2, DM * 2, S, E); } SEAM(1);
    if (IN(2)) {
        headgemm_wave<64, 256>(P.AQ + wave * 64, 512, P.WQ + (size_t)wave * 256 * 64, P.QL + wave * 256, 2048, [=](int i) { return vcu + i * G; }, (NTOK / 16 - vcu + G - 1) / G, lane);
#pragma nounroll
        for (int r0 = gw * 4; r0 < NTOK; r0 += NGW * 4) { u32x2 v[4]; f32x4 q4[4];
#pragma unroll
            for (int i = 0; i < 4; ++i) { bf16* kr = P.KV + (size_t)(r0 + i) * KVS; v[i] = *((const u32x2*)kr + lane); q4[i] = *(const f32x4*)(kr + 272); }
#pragma unroll
            for (int i = 0; i < 4; ++i) { const float rs = __builtin_amdgcn_rsqf(((q4[i].x + q4[i].y) + (q4[i].z + q4[i].w)) * (1.f / 256.f) + RMS_EPS);
                u32x2 o; o.x = cvt_pk_bf16(__uint_as_float(v[i].x << 16) * rs, __uint_as_float(v[i].x & 0xffff0000u) * rs); o.y = cvt_pk_bf16(__uint_as_float(v[i].y << 16) * rs, __uint_as_float(v[i].y & 0xffff0000u) * rs);
                *((u32x2*)(P.KV + (size_t)(r0 + i) * KVS) + lane) = o; } } } SEAM(2);
    if (IN(3)) { mixer_phase(P, lds, gw, NGW, wave, lane); } SEAM(3);
    if (NGW != 2048) {
        if (IN(4)) {
            headgemm_wave<256, 64>(P.OL + wave * 256, 2048, P.WV + (size_t)wave * 64 * 256, P.AB + wave * 64, 768, [=](int i) { return vcu + i * G; }, (NTOK / 16 - vcu + G - 1) / G, lane); } SEAM(4); }
    if (IN(5)) { gp::DenseOrder S; S.init(P.AB, P.WAB, 768 * 2, 768 * 2, NTOK, DM, G, bx); EpiUV E; E.G = P.G; E.MP = P.MP;
        gp::gemm_phase<EpiUV, gp::DenseOrder, false>(lds, 768, 768 * 2, 768 * 2, S, E); } SEAM(5);
    if (IN(6)) { gp::DenseOrder S; S.init(P.MP, P.WO, DM * 2, DM * 2, NTOK, DM, G, bx); EpiO E; E.x = P.x; E.PRE = P.out;
        gp::gemm_phase<EpiO, gp::DenseOrder, false>(lds, DM, DM * 2, DM * 2, S, E); } SEAM(6);
    if (IN(7)) { ln1_router_phase(P, lds, vcu, G, gw, NGW, wave, lane); } SEAM(7);
    if (IN(8)) { moe_table(P, MT); MoeOrder1 S; S.HBF = P.HBF; S.W13 = P.W13; S.LIST = P.LIST; S.T = MT; S.G = G; S.c = bx; EpiM1 E; E.HB = P.HB; E.WLIST = P.WLIST;
        gp::gemm_phase<EpiM1, MoeOrder1, true>(lds, DM, DM * 4, DM * 2, S, E);
        expert_weights_w2(P, lds, wave, lane); } SEAM(8);
    if (IN(9)) { moe_table(P, MT);
        MoeOrder2 S; S.HB = P.HB; S.W2 = P.W2; S.T = MT; S.G = G; S.c = bx; S.e_lo = 0; S.e_hi = 65; EpiM2R E; E.Y = (unsigned char*)P.Y; E.WLIST = P.WLIST; E.lds = lds;
        gp::gemm_phase<EpiM2R, MoeOrder2, false>(lds, DEXP, DEXP * 2, DEXP * 2, S, E); } SEAM(9);
    if (IN(10)) { moe_table(P, MT); combine_phase<true>(P, MT, 0, 64, gw, NGW, lane); }
#undef IN
#undef SEAM
}

#ifndef MK_N_LAUNCHES
#define MK_N_LAUNCHES 1
#endif
extern "C" void kernel_launch(void* const* d_in, const int* in_sizes, int n_in, void* d_out, int out_size, void* d_ws, size_t ws_size, hipStream_t stream) {
    static int grid = 0;
    if (grid == 0) {
        if (n_in != 22 || out_size != NTOK * DM || ws_size < WS_END) { fprintf(stderr, "kernel_launch: unexpected problem (n_in %d out %d ws %zu)\n", n_in, out_size, ws_size); grid = -1; return; }
        int dev = 0, cus = 0, per_cu = 0;
        if (hipGetDevice(&dev) != hipSuccess || hipDeviceGetAttribute(&cus, hipDeviceAttributeMultiprocessorCount, dev) != hipSuccess) { grid = -1; return; }
        if (hipFuncSetAttribute((const void*)fwd, hipFuncAttributeMaxDynamicSharedMemorySize, LDS_BYTES) != hipSuccess) { fprintf(stderr, "kernel_launch: hipFuncSetAttribute failed\n"); grid = -1; return; }
        if (hipOccupancyMaxActiveBlocksPerMultiprocessor(&per_cu, (const void*)fwd, NWAVES * 64, LDS_BYTES) != hipSuccess || per_cu < 1) fprintf(stderr, "kernel_launch: occupancy query reports %d\n", per_cu);
        (void)hipGetLastError();
        grid = cus;
    }
    if (grid < 0) return;
    (void)hipMemsetAsync((char*)d_ws + WS_CTL, 0, CTL_ZERO_BYTES, stream);
    Args a{};
    for (int i = 0; i < 22; ++i) a.in[i] = d_in[i];
    a.out = (float*)d_out; a.ws = (unsigned char*)d_ws;
    if (MK_N_LAUNCHES == 1) { a.ph_lo = 0; a.ph_hi = NPHASE; hipLaunchKernelGGL(fwd, dim3(grid), dim3(NWAVES * 64), LDS_BYTES, stream, a); }
    else for (int p = 0; p < NPHASE; ++p) { a.ph_lo = p; a.ph_hi = p + 1; hipLaunchKernelGGL(fwd, dim3(grid), dim3(NWAVES * 64), LDS_BYTES, stream, a); }
}
```

```cpp
#include <hip/hip_runtime.h>
#include <cstdio>
#include <cstdint>

#define LAS __attribute__((address_space(3)))
#define GAS __attribute__((address_space(1)))
typedef unsigned short bf16;
typedef short bf16x8 __attribute__((ext_vector_type(8)));
typedef short bf16x4 __attribute__((ext_vector_type(4)));
typedef int i32x4 __attribute__((ext_vector_type(4)));
typedef int i32x8 __attribute__((ext_vector_type(8)));
typedef float f32x4 __attribute__((ext_vector_type(4)));
typedef float f32x2 __attribute__((ext_vector_type(2)));
typedef unsigned u32x4 __attribute__((ext_vector_type(4)));
typedef unsigned u32x2 __attribute__((ext_vector_type(2)));
typedef GAS unsigned gu32;

constexpr int NTOK = 32768, DM = 1024, SEQ = 8192, NBATCH = 4;
constexpr int NIN = 5432, NINP = 5632;
constexpr int NEXP = 64, DEXP = 256;
constexpr float ALPHA = 1.189207115002721f;
constexpr float LN_EPS = 1e-5f, RMS_EPS = 1e-6f;
constexpr int KVS = 288;
constexpr int IN_AQ = 0, IN_CKV = 512, IN_AKR = 768, IN_IQ = 784, IN_IK = 1040, IN_IW = 1072, IN_BQ = 1080, IN_BK = 1848, IN_BV = 2616, IN_GA = 3384, IN_GB = 4408;

constexpr size_t MiB = 1u << 20;
constexpr size_t WS_CTL = 0, CTL_ZERO_BYTES = 128 * 1024;
constexpr size_t WS_R16 = 1 * MiB, WS_R8 = 3 * MiB;
constexpr size_t WS_WA = 4 * MiB, WS_WQ = 5 * MiB, WS_WV = 6 * MiB, WS_WO = 8 * MiB, WS_WB = 10 * MiB, WS_REC = 11 * MiB;
constexpr size_t WS_QL = 12 * MiB, WS_KV = 140 * MiB, WS_IQ = 158 * MiB, WS_AQ = 174 * MiB, WS_IK = 206 * MiB, WS_IW = 208 * MiB;
constexpr size_t WS_BQ = 210 * MiB, WS_BK = 258 * MiB, WS_BV = 306 * MiB, WS_BO = 354 * MiB;
constexpr size_t WS_WIN = 370 * MiB, WS_XB = 381 * MiB, WS_OL = 370 * MiB;
constexpr size_t WS_AO = 12 * MiB, WS_T1 = 44 * MiB, WS_MP = 108 * MiB;
constexpr size_t WS_HBF = 140 * MiB, WS_W13 = 204 * MiB, WS_LIST = 302 * MiB, WS_WLIST = 310 * MiB, WS_HB = 318 * MiB, WS_W2 = 471 * MiB, WS_Y = 12 * MiB;
constexpr size_t WS_X8 = 12 * MiB, WS_WG8 = 44 * MiB;
constexpr size_t WS_WAB = 498 * MiB;
constexpr size_t WS_END = 504 * MiB;
constexpr int CW_BAR = 4096;
constexpr int CW_W2Q = 8768;
constexpr int CW_BQ = 8192;
constexpr int CW_CNT = 16384;

constexpr int LDS_BYTES = 163840;
constexpr int LDS_BARW = LDS_BYTES - 64;
constexpr int NWAVES = 8;

typedef __bf16 bf16v2_t __attribute__((ext_vector_type(2)));
__device__ __forceinline__ unsigned cvt_pk_bf16(float lo, float hi) { const bf16v2_t r = __builtin_convertvector((f32x2){lo, hi}, bf16v2_t); return __builtin_bit_cast(unsigned, r); }
__device__ __forceinline__ float bf2f(unsigned b) { return __uint_as_float(b << 16); }
__device__ __forceinline__ float wave_sum(float v) {
#pragma unroll
    for (int o = 1; o < 64; o <<= 1) v += __shfl_xor(v, o);
    return v;
}
#define LDS_WAIT() asm volatile("s_waitcnt lgkmcnt(0)" ::: "memory")
#define VM_WAIT() asm volatile("s_waitcnt vmcnt(0)" ::: "memory")

#define XB_TMO      128
#define XB_XCNT(j)  (256  + 64 * (j))
#define XB_XSUB(j)  (1280 + 64 * (j))
#define XB_XGEN(j)  (2304 + 64 * (j))
#define XB_TOP      3328
#define XB_TOPGEN   3392
#define XCD_BAR_WORDS 3456
#define XB_SPIN_CAP (1u << 18)
__device__ __forceinline__ unsigned xb_ld(unsigned* p)              { return __hip_atomic_load(p, __ATOMIC_RELAXED, __HIP_MEMORY_SCOPE_AGENT); }
__device__ __forceinline__ unsigned xb_add(unsigned* p, unsigned v) { return __hip_atomic_fetch_add(p, v, __ATOMIC_RELAXED, __HIP_MEMORY_SCOPE_AGENT); }
__device__ __forceinline__ unsigned xb_xcc_id() { return (unsigned)__builtin_amdgcn_s_getreg((3 << 11) | 20) & 0xFu; }
#define XB_SPIN(cond, bar) do { unsigned _sp = 0; while (cond) { __builtin_amdgcn_s_sleep(1); \
    if ((++_sp & 255u) == 0u) { if (xb_ld(&(bar)[XB_TMO])) break; if (_sp > XB_SPIN_CAP) { atomicAdd(&(bar)[XB_TMO], 1u); break; } } } } while (0)
struct XcdBarrier { unsigned* bar; unsigned x; volatile LAS unsigned* st; };
__device__ __forceinline__ XcdBarrier xcd_barrier_post(unsigned* bar, volatile LAS unsigned* st) {
    XcdBarrier b; b.bar = bar; b.x = xb_xcc_id(); b.st = st;
    if (threadIdx.x == 0) (void)xb_add(&bar[XB_XCNT(b.x)], 1u);
    return b;
}
__device__ __forceinline__ void xcd_barrier_complete(unsigned* bar, unsigned x, unsigned& nloc, unsigned& nx) {
    const unsigned G = gridDim.x * gridDim.y * gridDim.z;
    unsigned sum, cnt, mine, sp = 0u;
    for (;;) {
        sum = 0u; cnt = 0u; mine = 0u;
#pragma unroll
        for (unsigned j = 0; j < 16; ++j) { const unsigned c = xb_ld(&bar[XB_XCNT(j)]); sum += c; cnt += (c > 0u) ? 1u : 0u; mine = (j == x) ? c : mine; }
        if (sum == G) break;
        __builtin_amdgcn_s_sleep(1);
        if ((++sp & 255u) == 0u) { if (xb_ld(&bar[XB_TMO])) break; if (sp > XB_SPIN_CAP) { atomicAdd(&bar[XB_TMO], 1u); break; } }
    }
    nloc = mine > 0u ? mine : 1u; nx = cnt > 0u ? cnt : 1u;
}
__device__ __forceinline__ void xcd_barrier(const XcdBarrier& b) {
    asm volatile("s_waitcnt vmcnt(0)" ::: "memory");
    __syncthreads();
    if (threadIdx.x == 0) {
        unsigned* bar = b.bar;
        __builtin_amdgcn_s_waitcnt(0);
        unsigned nloc = b.st[0], nx = b.st[1];
        if (nloc == 0u) { xcd_barrier_complete(bar, b.x, nloc, nx); b.st[0] = nloc; b.st[1] = nx; }
        const unsigned old = xb_add(&bar[XB_XSUB(b.x)], 1u);
        const unsigned gen = old / nloc;
        if (old + 1u == (gen + 1u) * nloc) {
            __builtin_amdgcn_fence(__ATOMIC_RELEASE, "agent");
            asm volatile("s_waitcnt vmcnt(0)" ::: "memory");
            const unsigned og = xb_add(&bar[XB_TOP], 1u);
            const unsigned tg = og / nx;
            if (og + 1u == (tg + 1u) * nx) xb_add(&bar[XB_TOPGEN], 1u);
            else XB_SPIN(xb_ld(&bar[XB_TOPGEN]) == tg, bar);
            __builtin_amdgcn_fence(__ATOMIC_ACQUIRE, "agent");
            xb_add(&bar[XB_XGEN(b.x)], 1u);
            asm volatile("s_waitcnt vmcnt(0)" ::: "memory");
        } else {
            XB_SPIN(xb_ld(&bar[XB_XGEN(b.x)]) == gen, bar);
            __builtin_amdgcn_fence(__ATOMIC_ACQUIRE, "agent");
            asm volatile("s_waitcnt vmcnt(0)" ::: "memory");
        }
    }
    __syncthreads();
}

namespace gp {
constexpr int BM = 256, BK = 64, HALF = 128, HTB = HALF * BK * 2, STAGE_BYTES = 8 * HTB, NXCD = 8, WGM = 8;
__host__ __device__ __forceinline__ int lds_byte(int r, int c) { const int st = (r >> 4) * 2 + (c >> 5), rr = r & 15, cc = c & 31, ob = rr * 64 + cc * 2; return st * 1024 + (ob ^ (((ob >> 9) & 1) << 5)); }
__host__ __device__ __forceinline__ int perm32(int rho) { const int n = rho >> 4, i = rho & 15; return 8 * (i >> 2) + 4 * n + (i & 3); }
__host__ __device__ __forceinline__ void stage_rc(int b, int& R, int& C) { const int st = b / 1024, sb = b % 1024, swz = sb ^ (((sb >> 9) & 1) << 5); R = (st >> 1) * 16 + swz / 64; C = (st & 1) * 32 + (swz % 64) / 2; }

struct U { const char* A; const char* B; const int* rows; int rbase; int nvalid; int r0; int c0; int x0; int x1; };

__device__ __forceinline__ int xcd_chunk(int L, int n) { const int q = n / NXCD, r = n % NXCD, xcd = L % NXCD, off = L / NXCD; return (xcd < r ? xcd * (q + 1) : r * (q + 1) + (xcd - r) * q) + off; }
struct DenseOrder {
    const char* A; const char* B; int lda, ldb; int nM, nN, nwg, G, c, bn;
    __device__ void init(const void* A_, const void* B_, int lda_, int ldb_, int M, int N, int G_, int c_, int bn_ = BM) { A = (const char*)A_; B = (const char*)B_; lda = lda_; ldb = ldb_; bn = bn_; nM = M / BM; nN = N / bn_; nwg = nM * nN; G = G_; c = c_; }
    __device__ __forceinline__ bool next(int i, U& u) const {
        const long L = (long)i * G + c; if (L >= nwg) return false;
        int wgid = (int)L; { const int q = nwg / NXCD, r = nwg % NXCD, xcd = wgid % NXCD, off = wgid / NXCD; wgid = (xcd < r ? xcd * (q + 1) : r * (q + 1) + (xcd - r) * q) + off; }
        const int nig = WGM * nN, gid = wgid / nig, fm = gid * WGM, gsz = (nM - fm) < WGM ? (nM - fm) : WGM;
        const int pm = fm + ((wgid % nig) % gsz), pn = (wgid % nig) / gsz;
        u.A = A + (size_t)pm * BM * lda; u.B = B + (size_t)pn * bn * ldb; u.rows = nullptr; u.rbase = 0; u.nvalid = 256; u.r0 = pm * BM; u.c0 = pn; u.x0 = 0; u.x1 = 0;
        return true;
    }
};

template <class Epi, class Sched, bool GATHER, bool F8 = false, int NB = 2>
__device__ __forceinline__ void gemm_phase(LAS unsigned char* lds, const int K, const int lda, const int ldb, const Sched& S, const Epi& E) {
    const int tid = threadIdx.x, wid = __builtin_amdgcn_readfirstlane(tid >> 6), lane = tid & 63, wr = wid >> 2, wc = wid & 3, fr = lane & 15, fq = lane >> 4;
    const int nt = K / BK;
    int R0, C0, R1, C1; stage_rc(tid * 16, R0, C0); stage_rc(tid * 16 + 8192, R1, C1);
    const int Rb0 = Epi::PERM ? ((R0 & ~31) + perm32(R0 & 31)) : R0, Rb1 = Epi::PERM ? ((R1 & ~31) + perm32(R1 & 31)) : R1;
    const unsigned voffB0 = (unsigned)(Rb0 * ldb + C0 * 2), voffB1 = (unsigned)(Rb1 * ldb + C1 * 2);
    const size_t kstep = (size_t)(BK * 2);
    const size_t hstepB = (size_t)HALF * ldb;
    const unsigned ldsw = (unsigned)wid * 1024u;
    const int aoff = lds_byte(wr * 64 + fr, fq * 8), boff = lds_byte(wc * 32 + fr, fq * 8);
#define GP_SA(b, h) (((b) * 2 + (h)) * HTB)
#define GP_SB(b, h) ((4 + (b) * 2 + (h)) * HTB)
#define GP_STAGE2(bufoff, gptr, v0, v1) do { \
        __builtin_amdgcn_global_load_lds((const unsigned*)((const char*)(gptr) + (v0)), (LAS unsigned*)(lds + (bufoff) + ldsw), 16, 0, 0); \
        __builtin_amdgcn_global_load_lds((const unsigned*)((const char*)(gptr) + (v1)), (LAS unsigned*)(lds + (bufoff) + ldsw + 8192), 16, 0, 0); } while (0)
#define GP_STB(bufoff, gptr) GP_STAGE2(bufoff, gptr, voffB0, voffB1)
#define GP_LDA(dst, b, h) do { _Pragma("unroll") for (int m = 0; m < 4; ++m) { \
        if constexpr (F8) { dst##8[m].lo = *(const LAS i32x4*)(lds + GP_SA(b, h) + aoff + m * 2048); dst##8[m].hi = *(const LAS i32x4*)(lds + GP_SA(b, h) + aoff + m * 2048 + 1024); } \
        else { _Pragma("unroll") for (int k = 0; k < 2; ++k) dst[m][k] = *(const LAS bf16x8*)(lds + GP_SA(b, h) + aoff + m * 2048 + k * 1024); } } } while (0)
#define GP_LDB(dst, b, h) do { _Pragma("unroll") for (int n = 0; n < 2; ++n) { \
        if constexpr (F8) { dst##8[n].lo = *(const LAS i32x4*)(lds + GP_SB(b, h) + boff + n * 2048); dst##8[n].hi = *(const LAS i32x4*)(lds + GP_SB(b, h) + boff + n * 2048 + 1024); } \
        else { _Pragma("unroll") for (int k = 0; k < 2; ++k) dst[n][k] = *(const LAS bf16x8*)(lds + GP_SB(b, h) + boff + n * 2048 + k * 1024); } } } while (0)
#define GP_MMA(ai, bj, At, Bt) do { __builtin_amdgcn_s_setprio(1); _Pragma("unroll") for (int m = 0; m < 4; ++m) _Pragma("unroll") for (int n = 0; n < 2; ++n) { \
        if constexpr (F8) acc[ai][bj][m][n] = __builtin_amdgcn_mfma_scale_f32_16x16x128_f8f6f4(Bt##8[n], At##8[m], acc[ai][bj][m][n], 0, 0, 0, 121, 0, 127); \
        else { _Pragma("unroll") for (int k = 0; k < 2; ++k) acc[ai][bj][m][n] = __builtin_amdgcn_mfma_f32_16x16x32_bf16(Bt[n][k], At[m][k], acc[ai][bj][m][n], 0, 0, 0); } } \
        __builtin_amdgcn_s_setprio(0); } while (0)
#define GP_WAIT_V(n) asm volatile("s_waitcnt vmcnt(" #n ")" ::: "memory")
#define GP_WAIT_VS do { if constexpr (NB == 2) GP_WAIT_V(8); else GP_WAIT_V(6); } while (0)
#define GP_WAIT_L(n) asm volatile("s_waitcnt lgkmcnt(" #n ")" ::: "memory")
#define GP_BAR __builtin_amdgcn_s_barrier()
#define GP_SCHED __builtin_amdgcn_sched_barrier(0)
#define GP_AOFF(u, v00, v01, v10, v11) do { \
        if (GATHER) { int t00, t01, t10, t11; \
            if ((u).rows) { t00 = R0 < (u).nvalid ? (u).rows[R0] : 0; t01 = R1 < (u).nvalid ? (u).rows[R1] : 0; t10 = R0 + HALF < (u).nvalid ? (u).rows[R0 + HALF] : 0; t11 = R1 + HALF < (u).nvalid ? (u).rows[R1 + HALF] : 0; } \
            else { t00 = (u).rbase + R0; t01 = (u).rbase + R1; t10 = (u).rbase + R0 + HALF; t11 = (u).rbase + R1 + HALF; } \
            v00 = (unsigned)(t00 * lda + C0 * 2); v01 = (unsigned)(t01 * lda + C1 * 2); v10 = (unsigned)(t10 * lda + C0 * 2); v11 = (unsigned)(t11 * lda + C1 * 2); } \
        else { v00 = (unsigned)(R0 * lda + C0 * 2); v01 = (unsigned)(R1 * lda + C1 * 2); v10 = (unsigned)((R0 + HALF) * lda + C0 * 2); v11 = (unsigned)((R1 + HALF) * lda + C1 * 2); } } while (0)
    U cur, nxt; int ui = 0;
    if (!S.next(0, cur)) return;
    f32x4 acc[2][NB][4][2];
#pragma unroll
    for (int a = 0; a < 2; ++a)
#pragma unroll
        for (int b = 0; b < NB; ++b)
#pragma unroll
            for (int m = 0; m < 4; ++m)
#pragma unroll
                for (int n = 0; n < 2; ++n) acc[a][b][m][n] = (f32x4){0.f, 0.f, 0.f, 0.f};
    bf16x8 At[4][2], B0[2][2], B1[2][2]; i32x8 At8[4], B08[2], B18[2];
    unsigned c00, c01, c10, c11, n00, n01, n10, n11;
    GP_AOFF(cur, c00, c01, c10, c11);
    n00 = c00; n01 = c01; n10 = c10; n11 = c11;
    const char* cA = cur.A; const char* cB = cur.B;
    GP_STB(GP_SB(0, 0), cB); if constexpr (NB == 2) GP_STB(GP_SB(0, 1), cB + hstepB); GP_STAGE2(GP_SA(0, 0), cA, c00, c01); GP_STAGE2(GP_SA(0, 1), cA, c10, c11);
    if (wr == 1) GP_BAR;
    GP_WAIT_V(2); GP_BAR;
    GP_STB(GP_SB(1, 0), cB + kstep); GP_STAGE2(GP_SA(1, 0), cA + kstep, c00, c01); if constexpr (NB == 2) GP_STB(GP_SB(1, 1), cB + hstepB + kstep);
    if constexpr (NB == 2) GP_WAIT_V(6); else GP_WAIT_V(4);
    GP_BAR;
    for (;;) {
        const bool has_next = S.next(ui + 1, nxt);
        const char* nA = has_next ? nxt.A : cA; const char* nB = has_next ? nxt.B : cB;
        if (GATHER) { if (has_next) GP_AOFF(nxt, n00, n01, n10, n11); else { n00 = c00; n01 = c01; n10 = c10; n11 = c11; } }
#pragma nounroll
        for (int t = 0; t < nt; t += 2) {
            if constexpr (Epi::MID_T > 0) { if (t == Epi::MID_T) E.mid(acc, cur, wr, wc, fr, fq); }
            const bool last = (t == nt - 2);
            const char* a1 = cA + (size_t)(t + 1) * kstep;
            const char* a2 = last ? nA : cA + (size_t)(t + 2) * kstep; const char* b2 = last ? nB : cB + (size_t)(t + 2) * kstep;
            const char* a3 = a2 + kstep; const char* b3 = b2 + kstep;
            unsigned s00 = c00, s01 = c01, s10 = c10, s11 = c11;
            if (GATHER) { s00 = last ? n00 : c00; s01 = last ? n01 : c01; s10 = last ? n10 : c10; s11 = last ? n11 : c11; }
            GP_LDB(B0, 0, 0); if constexpr (NB == 2) GP_LDB(B1, 0, 1); GP_SCHED; GP_LDA(At, 0, 0); GP_STAGE2(GP_SA(1, 1), a1, c10, c11);
            GP_WAIT_VS; GP_WAIT_L(0); GP_BAR; GP_MMA(0, 0, At, B0); if constexpr (NB == 2) GP_MMA(0, 1, At, B1); GP_BAR; GP_SCHED;
            GP_LDA(At, 0, 1); GP_STB(GP_SB(0, 0), b2); if constexpr (NB == 2) GP_STB(GP_SB(0, 1), b2 + hstepB); GP_STAGE2(GP_SA(0, 0), a2, s00, s01);
            GP_WAIT_VS; GP_WAIT_L(0); GP_BAR; GP_MMA(1, 0, At, B0); if constexpr (NB == 2) GP_MMA(1, 1, At, B1); GP_BAR; GP_SCHED;
            GP_LDB(B0, 1, 0); if constexpr (NB == 2) GP_LDB(B1, 1, 1); GP_SCHED; GP_LDA(At, 1, 0); GP_STAGE2(GP_SA(0, 1), a2, s10, s11);
            GP_WAIT_VS; GP_WAIT_L(0); GP_BAR; GP_MMA(0, 0, At, B0); if constexpr (NB == 2) GP_MMA(0, 1, At, B1); GP_BAR; GP_SCHED;
            GP_LDA(At, 1, 1); GP_STB(GP_SB(1, 0), b3); if constexpr (NB == 2) GP_STB(GP_SB(1, 1), b3 + hstepB); GP_STAGE2(GP_SA(1, 0), a3, s00, s01);
            GP_WAIT_VS; GP_WAIT_L(0); GP_BAR; GP_MMA(1, 0, At, B0); if constexpr (NB == 2) GP_MMA(1, 1, At, B1); GP_BAR; GP_SCHED;
        }
        if (wr == 0) GP_BAR;
        E(acc, cur, wr, wc, fr, fq);
        if (!has_next) break;
#pragma unroll
        for (int a = 0; a < 2; ++a)
#pragma unroll
            for (int b = 0; b < NB; ++b)
#pragma unroll
                for (int m = 0; m < 4; ++m)
#pragma unroll
                    for (int n = 0; n < 2; ++n) acc[a][b][m][n] = (f32x4){0.f, 0.f, 0.f, 0.f};
        cur = nxt; cA = nA; cB = nB; ++ui;
        c00 = n00; c01 = n01; c10 = n10; c11 = n11;
        if (wr == 1) GP_BAR;
    }
    GP_WAIT_V(0);
    GP_BAR;
#undef GP_SA
#undef GP_SB
#undef GP_STAGE2
#undef GP_STB
#undef GP_LDA
#undef GP_LDB
#undef GP_MMA
#undef GP_WAIT_V
#undef GP_WAIT_VS
#undef GP_WAIT_L
#undef GP_BAR
#undef GP_SCHED
#undef GP_AOFF
}
}

struct Args { const void* in[22]; float* out; unsigned char* ws; int ph_lo, ph_hi; };

struct Ptrs {
    const float *x, *w_in, *b_gate, *g_kv, *w_uk, *w_uv, *w_ba, *w_bb, *w_o, *ln1_g, *ln1_b, *w_router, *router_bias, *w1_e, *w3_e, *w2_e, *ws1, *ws3, *ws2, *ln2_g, *ln2_b;
    const int* positions;
    float* out; unsigned char* ws; gu32* ctl;
    bf16 *XB, *WIN, *WQ, *WV, *WO, *QL, *KV, *IQ, *AQ, *IK, *BQ, *BK, *BV, *OL, *AB, *WAB, *MP, *HBF, *W13, *W2, *HB, *Y;
    unsigned char *X8, *WG8;
    unsigned char* G;
    float *IW; f32x2 *R16, *R8; unsigned* REC; int* LIST; float* WLIST;
};

constexpr float YSCALE = 16.f;
__device__ __forceinline__ unsigned pk4_fp8(float a, float b, float c, float d) { unsigned w = 0u; w = __builtin_amdgcn_cvt_pk_fp8_f32(a, b, w, false); w = __builtin_amdgcn_cvt_pk_fp8_f32(c, d, w, true); return w; }
__device__ __forceinline__ f32x4 up4_fp8(unsigned w) { const f32x2 lo = __builtin_amdgcn_cvt_pk_f32_fp8((int)w, false), hi = __builtin_amdgcn_cvt_pk_f32_fp8((int)w, true); return (f32x4){lo.x, lo.y, hi.x, hi.y}; }
__device__ __forceinline__ void st4(bf16* p, f32x4 v) { u32x2 w; w.x = cvt_pk_bf16(v.x, v.y); w.y = cvt_pk_bf16(v.z, v.w); *(u32x2*)p = w; }
__device__ __forceinline__ void st8(bf16* p, f32x4 a, f32x4 b) { u32x4 w; w.x = cvt_pk_bf16(a.x, a.y); w.y = cvt_pk_bf16(a.z, a.w); w.z = cvt_pk_bf16(b.x, b.y); w.w = cvt_pk_bf16(b.z, b.w); *(u32x4*)p = w; }
__device__ __forceinline__ void st8nt(bf16* p, f32x4 a, f32x4 b) { u32x4 w; w.x = cvt_pk_bf16(a.x, a.y); w.y = cvt_pk_bf16(a.z, a.w); w.z = cvt_pk_bf16(b.x, b.y); w.w = cvt_pk_bf16(b.z, b.w); __builtin_nontemporal_store(w, (u32x4*)p); }
__device__ __forceinline__ void ld8bf(const bf16* p, f32x4& a, f32x4& b) { const u32x4 w = *(const u32x4*)p; a = (f32x4){__uint_as_float(w.x << 16), __uint_as_float(w.x & 0xffff0000u), __uint_as_float(w.y << 16), __uint_as_float(w.y & 0xffff0000u)}; b = (f32x4){__uint_as_float(w.z << 16), __uint_as_float(w.z & 0xffff0000u), __uint_as_float(w.w << 16), __uint_as_float(w.w & 0xffff0000u)}; }
__device__ __forceinline__ f32x4 ld4bf(const bf16* p) { const u32x2 w = *(const u32x2*)p; return (f32x4){__uint_as_float(w.x << 16), __uint_as_float(w.x & 0xffff0000u), __uint_as_float(w.y << 16), __uint_as_float(w.y & 0xffff0000u)}; }
__device__ __forceinline__ f32x4 rope4(f32x4 v, f32x4 cs) { return (f32x4){v.x * cs.x - v.y * cs.y, v.y * cs.x + v.x * cs.y, v.z * cs.z - v.w * cs.w, v.w * cs.z + v.z * cs.w}; }

__device__ __forceinline__ void tr_item(const float* W, int ldw, int k0, int sc, float scale, bf16* WT, size_t ldd, int n0, LAS float* scr, int lane) {
#pragma unroll 8
    for (int i = 0; i < 32; ++i) { const int kk = 2 * i + (lane >> 5); scr[kk * 33 + (lane & 31)] = sc >= 0 ? W[(size_t)(k0 + kk) * ldw + sc] * scale : 0.f; }
    LDS_WAIT(); asm volatile("" ::: "memory");
    const int c = lane & 7;
#pragma unroll
    for (int j = 0; j < 4; ++j) { const int n = (lane >> 3) + 8 * j; const LAS float* s = scr + (8 * c) * 33 + n;
        u32x4 o; o.x = cvt_pk_bf16(s[0 * 33], s[1 * 33]); o.y = cvt_pk_bf16(s[2 * 33], s[3 * 33]); o.z = cvt_pk_bf16(s[4 * 33], s[5 * 33]); o.w = cvt_pk_bf16(s[6 * 33], s[7 * 33]);
        *(u32x4*)(WT + (size_t)(n0 + n) * ldd + k0 + 8 * c) = o; }
    LDS_WAIT(); asm volatile("" ::: "memory");
}
__device__ __forceinline__ void tr_load(const float* W, int ldw, int k0, int sc, float (&v)[32], int lane) {
#pragma unroll
    for (int i = 0; i < 32; ++i) v[i] = sc >= 0 ? W[(size_t)(k0 + 2 * i + (lane >> 5)) * ldw + sc] : 0.f;
}
__device__ __forceinline__ void tr_finish(const float (&v)[32], float scale, bf16* WT, size_t ldd, int n0, int k0, int lane) {
    unsigned w[32];
#pragma unroll
    for (int i = 0; i < 32; ++i) { const auto r = __builtin_amdgcn_permlane32_swap(__float_as_uint(v[i]), __float_as_uint(v[i]), false, false);
        w[i] = cvt_pk_bf16(__uint_as_float(r[0]) * scale, __uint_as_float(r[1]) * scale); }
    const bool up = lane >= 32; bf16* dst = WT + (size_t)(n0 + (lane & 31)) * ldd + k0 + (up ? 32 : 0);
#pragma unroll
    for (int j = 0; j < 4; ++j) { u32x4 o; o.x = up ? w[16 + 4 * j] : w[4 * j]; o.y = up ? w[17 + 4 * j] : w[4 * j + 1]; o.z = up ? w[18 + 4 * j] : w[4 * j + 2]; o.w = up ? w[19 + 4 * j] : w[4 * j + 3];
        *(u32x4*)(dst + 8 * j) = o; }
}
__device__ __forceinline__ void tr_finish8(const float (&v)[32], float scale, unsigned char* WT8, size_t ldd, int n0, int k0, int lane, int rowl = -1) {
    unsigned w[16];
#pragma unroll
    for (int j = 0; j < 16; ++j) { const auto ra = __builtin_amdgcn_permlane32_swap(__float_as_uint(v[2 * j]), __float_as_uint(v[2 * j]), false, false);
        const auto rb = __builtin_amdgcn_permlane32_swap(__float_as_uint(v[2 * j + 1]), __float_as_uint(v[2 * j + 1]), false, false);
        w[j] = pk4_fp8(__uint_as_float(ra[0]) * scale, __uint_as_float(ra[1]) * scale, __uint_as_float(rb[0]) * scale, __uint_as_float(rb[1]) * scale); }
    unsigned char* dst = WT8 + (size_t)(rowl >= 0 ? rowl : n0 + (lane & 31)) * ldd + k0;
    if (lane < 32) { *(u32x4*)dst = (u32x4){w[0], w[1], w[2], w[3]}; *(u32x4*)(dst + 16) = (u32x4){w[4], w[5], w[6], w[7]}; }
    else { *(u32x4*)(dst + 32) = (u32x4){w[8], w[9], w[10], w[11]}; *(u32x4*)(dst + 48) = (u32x4){w[12], w[13], w[14], w[15]}; }
}
__device__ __forceinline__ void win_src(int n, int& sc, float& scale) {
    const int pn = n >> 8, c = n & 255; scale = 1.f; sc = -1;
    if (pn < 2) { const int cc = pn * 256 + c, hh = cc >> 6, dd = cc & 63; const int o = dd < 16 ? (dd >> 1) + 8 * (dd & 1) : dd; sc = IN_AQ + hh * 64 + o; scale = 0.125f; }
    else if (pn == 2) sc = IN_CKV + c;
    else if (pn == 3) { const int hh = c >> 5, dd = c & 31; const int o = dd < 8 ? (dd >> 1) + 4 * (dd & 1) : dd; sc = IN_IQ + hh * 32 + o; }
    else if (pn == 4) {
        if (c < 16) sc = IN_AKR + (c >> 1) + 8 * (c & 1);
        else if (c < 48) { const int dd = c - 16; sc = IN_IK + (dd < 8 ? (dd >> 1) + 4 * (dd & 1) : dd); }
        else if (c < 56) { sc = IN_IW + (c - 48); scale = 0.0625f; }
    }
    else if (pn < 11) { const int isk = pn >= 8; const int cc = (pn - (isk ? 8 : 5)) * 256 + c, hh = cc >> 6, dd = cc & 63; const int o = dd < 16 ? (dd >> 1) + 8 * (dd & 1) : dd; sc = (isk ? IN_BK : IN_BQ) + hh * 64 + o; scale = isk ? 1.f : 0.125f; }
    else if (pn < 14) sc = IN_BV + (pn - 11) * 256 + c;
    else { const int co = 64 * ((c >> 5) & 3) + 16 * ((c >> 3) & 3) + 8 * (c >> 7) + (c & 7);
        sc = (pn < 18 ? IN_GA + (pn - 14) * 256 : IN_GB + (pn - 18) * 256) + co; }
}
__device__ __forceinline__ void p0_phase(const Ptrs& P, LAS unsigned char* lds, int gw, int NGW, int wave, int lane) {
    LAS float* scr = (LAS float*)(lds + wave * 16384);
    float cw[32]; int csc = -1; float cscale = 1.f; const bool chas = gw < 16 * 16;
    if (chas) { win_src((24 + (gw >> 4)) * 32 + (lane & 31), csc, cscale); tr_load(P.w_in, NIN, (gw & 15) * 64, csc, cw, lane); }
    for (int m0 = gw; m0 < NTOK; m0 += 4 * NGW) { f32x4 v[4][4];
#pragma unroll
        for (int r = 0; r < 4; ++r) { const int m = min(m0 + r * NGW, NTOK - 1); const f32x4* xr = (const f32x4*)(P.x + (size_t)m * DM) + lane;
#pragma unroll
            for (int j = 0; j < 4; ++j) v[r][j] = xr[64 * j]; }
#pragma unroll
        for (int r = 0; r < 4; ++r) { const int m = m0 + r * NGW; if (m < NTOK) { u32x2* o = (u32x2*)(P.XB + (size_t)m * DM) + lane;
#pragma unroll
            for (int j = 0; j < 4; ++j) { u32x2 w; w.x = cvt_pk_bf16(v[r][j].x, v[r][j].y); w.y = cvt_pk_bf16(v[r][j].z, v[r][j].w); o[64 * j] = w;
                ((unsigned*)(P.X8 + (size_t)m * DM))[lane + 64 * j] = pk4_fp8(v[r][j].x, v[r][j].y, v[r][j].z, v[r][j].w); } } } }
    if (chas) tr_finish(cw, cscale, P.WIN, DM, (24 + (gw >> 4)) * 32, (gw & 15) * 64, lane);
    for (int i = gw * 64 + lane; i < NTOK * 12; i += NGW * 64) { const int tok = i / 12, a = i % 12;
        const float inv = a < 8 ? exp2f(-(float)a * (18.931568569324174f / 8.f)) : exp2f(-(float)(a - 8) * (18.931568569324174f / 4.f));
        const float ang = (float)P.positions[tok] * inv;
        double rev = (double)ang * 0.15915494309189535; rev -= floor(rev); const float fr = (float)rev;
        const f32x2 cs = (f32x2){__builtin_amdgcn_cosf(fr), __builtin_amdgcn_sinf(fr)};
        if (a < 8) P.R16[tok * 8 + a] = cs; else P.R8[tok * 4 + (a - 8)] = cs; }
    for (int it = gw + NGW; it < 16 * 16; it += NGW) { const int ng = 24 + (it >> 4), kb = it & 15, n0 = ng * 32; int sc; float scale; win_src(n0 + (lane & 31), sc, scale);
        tr_item(P.w_in, NIN, kb * 64, sc, scale, P.WIN, DM, n0, scr, lane); }
    for (int i = gw * 64 + lane; i < 8 * 256 * 64; i += NGW * 64) { const int dd = i & 63, r = (i >> 6) & 255, h = i >> 14;
        const float v = dd < 16 ? 0.f : P.g_kv[r] * P.w_uk[((size_t)r * 8 + h) * 48 + dd - 16]; P.WQ[i] = (bf16)(cvt_pk_bf16(v, 0.f) & 0xffffu); }
    for (int i = gw * 64 + lane; i < 8 * 64 * 256; i += NGW * 64) { const int r = i & 255, d = (i >> 8) & 63, h = i >> 14;
        const float v = P.g_kv[r] * P.w_uv[((size_t)r * 8 + h) * 64 + d]; P.WV[i] = (bf16)(cvt_pk_bf16(v, 0.f) & 0xffffu); }
    for (int it = (gw + NGW - 256 % NGW) % NGW; it < 160 * 16; it += NGW) { const int ng = it >> 4, kb = it & 15, n = ng * 32 + (lane & 31);
        int sc; float scale_; if (n < 2048) sc = n < 1024 ? IN_GA + n : IN_GB + (n - 1024); else win_src(n < 4352 ? 1280 + (n - 2048) : (n < 4608 ? 512 + (n - 4352) : n - 4608), sc, scale_);
        float gv[32]; tr_load(P.w_in, NIN, kb * 64, sc, gv, lane); tr_finish8(gv, 64.f, P.WG8, DM, ng * 32, kb * 64, lane); }
    for (int it = (gw + NGW - 768 % NGW) % NGW; it < 8 * 32; it += NGW) { const int kb = it >> 5, nb = it & 31; tr_item(P.w_ba, DM, kb * 64, nb * 32 + (lane & 31), 1.f, P.WAB, 768, nb * 32, scr, lane); }
    for (int it = (gw + NGW - 1024 % NGW) % NGW; it < 4 * 32; it += NGW) { const int kb = it >> 5, nb = it & 31; tr_item(P.w_bb, DM, kb * 64, nb * 32 + (lane & 31), 1.f, P.WAB + 512, 768, nb * 32, scr, lane); }
    for (int it = (gw + NGW - 1152 % NGW) % NGW; it < 16 * 32; it += NGW) { const int kb = it >> 5, nb = it & 31; tr_item(P.w_o, DM, kb * 64, nb * 32 + (lane & 31), 1.f, P.WO, DM, nb * 32, scr, lane); }
}

struct EpiP1 {
    static constexpr bool PERM = true; static constexpr int MID_T = 0;
    Ptrs P;
    __device__ __forceinline__ void operator()(const f32x4 (&acc)[2][2][4][2], const gp::U& u, int wr, int wc, int fr, int fq) const {
        const int pn = u.c0 + 3, row0 = u.r0 + wr * 64 + fr, c8 = wc * 32 + 8 * fq;
#define P1_ROW(gi) (row0 + ((gi) >> 2) * 128 + ((gi) & 3) * 16)
        if (pn == 3) {
            f32x4 ca[2], cb[2]; ca[0] = *(const f32x4*)(P.R8 + (size_t)row0 * 4); cb[0] = *(const f32x4*)(P.R8 + (size_t)row0 * 4 + 2);
#pragma unroll
            for (int gi = 0; gi < 8; ++gi) { const int ai = gi >> 2, m = gi & 3; const int row = P1_ROW(gi);
                if (gi < 7) { const int rn = P1_ROW(gi + 1); ca[(gi + 1) & 1] = *(const f32x4*)(P.R8 + (size_t)rn * 4); cb[(gi + 1) & 1] = *(const f32x4*)(P.R8 + (size_t)rn * 4 + 2); }
                asm volatile("" ::: "memory");
#pragma unroll
                for (int bj = 0; bj < 2; ++bj) { f32x4 v0 = acc[ai][bj][m][0], v1 = acc[ai][bj][m][1]; if (fq == 0) { v0 = rope4(v0, ca[gi & 1]); v1 = rope4(v1, cb[gi & 1]); } st8(P.IQ + (size_t)row * 256 + bj * 128 + c8, v0, v1); } }
        } else {
            const bool r16 = wc == 0 && fq < 2;
            const f32x2* tb = r16 ? P.R16 : P.R8; const int ts = r16 ? 8 : 4, to = r16 ? 4 * fq : 0;
            f32x4 ca[2], cb[2]; ca[0] = *(const f32x4*)(tb + (size_t)row0 * ts + to); cb[0] = *(const f32x4*)(tb + (size_t)row0 * ts + to + 2);
#pragma unroll
            for (int gi = 0; gi < 8; ++gi) { const int ai = gi >> 2, m = gi & 3; const int row = P1_ROW(gi);
                if (gi < 7) { const int rn = P1_ROW(gi + 1); ca[(gi + 1) & 1] = *(const f32x4*)(tb + (size_t)rn * ts + to); cb[(gi + 1) & 1] = *(const f32x4*)(tb + (size_t)rn * ts + to + 2); }
                asm volatile("" ::: "memory");
                const f32x4 v0 = acc[ai][0][m][0], v1 = acc[ai][0][m][1];
                if (wc == 0) {
                    if (fq < 2) st8(P.KV + (size_t)row * KVS + 256 + 8 * fq, rope4(v0, ca[gi & 1]), rope4(v1, cb[gi & 1]));
                    else if (fq == 2) st8(P.IK + (size_t)row * 32, rope4(v0, ca[gi & 1]), rope4(v1, cb[gi & 1]));
                    else st8(P.IK + (size_t)row * 32 + 8, v0, v1);
                } else if (wc == 1) {
                    if (fq < 2) st8(P.IK + (size_t)row * 32 + 16 + 8 * fq, v0, v1);
                    else if (fq == 2) { *(f32x4*)(P.IW + (size_t)row * 8) = v0; *(f32x4*)(P.IW + (size_t)row * 8 + 4) = v1; }
                } }
        }
#undef P1_ROW
    }
};

template <int K, int N, bool OUT8 = false, bool IN8 = false, class GF>
__device__ __forceinline__ void headgemm_wave(const bf16* X, int ldx, const bf16* W, bf16* OUT, int ldo, const GF& gf, int ngrp, int lane) {
    const int fr = lane & 15, fq = lane >> 4;
    bf16x8 wf[N / 16][K / 32];
#pragma unroll
    for (int nt = 0; nt < N / 16; ++nt)
#pragma unroll
        for (int s = 0; s < K / 32; ++s) wf[nt][s] = *(const bf16x8*)(W + (size_t)(32 * (nt >> 1) + 8 * (fr >> 2) + 4 * (nt & 1) + (fr & 3)) * K + 32 * s + 8 * fq);
    bf16x8 xn[K / 32]; u32x2 x8n[K / 32];
#pragma unroll
    for (int s = 0; s < K / 32; ++s) { if constexpr (IN8) x8n[s] = *(const u32x2*)((const unsigned char*)X + ((size_t)gf(0) * 16 + fr) * ldx + 32 * s + 8 * fq); else xn[s] = *(const bf16x8*)(X + ((size_t)gf(0) * 16 + fr) * ldx + 32 * s + 8 * fq); }
#pragma nounroll
    for (int gi = 0; gi < ngrp; ++gi) { const int t16 = gf(gi);
        bf16x8 xf[K / 32];
#pragma unroll
        for (int s = 0; s < K / 32; ++s) { if constexpr (IN8) { const f32x4 lo = up4_fp8(x8n[s].x) * 0.125f, hi = up4_fp8(x8n[s].y) * 0.125f; u32x4 pk; pk.x = cvt_pk_bf16(lo.x, lo.y); pk.y = cvt_pk_bf16(lo.z, lo.w); pk.z = cvt_pk_bf16(hi.x, hi.y); pk.w = cvt_pk_bf16(hi.z, hi.w); xf[s] = __builtin_bit_cast(bf16x8, pk); } else xf[s] = xn[s]; }
        const int tn = gf(min(gi + 1, ngrp - 1));
#pragma unroll
        for (int s = 0; s < K / 32; ++s) { if constexpr (IN8) x8n[s] = *(const u32x2*)((const unsigned char*)X + ((size_t)tn * 16 + fr) * ldx + 32 * s + 8 * fq); else xn[s] = *(const bf16x8*)(X + ((size_t)tn * 16 + fr) * ldx + 32 * s + 8 * fq); }
        bf16* op = OUT + ((size_t)t16 * 16 + fr) * ldo + 8 * fq;
#pragma unroll
        for (int np = 0; np < N / 32; ++np) {
            f32x4 a0 = (f32x4){0.f, 0.f, 0.f, 0.f}, a1 = (f32x4){0.f, 0.f, 0.f, 0.f};
#pragma unroll
            for (int s = 0; s < K / 32; ++s) { a0 = __builtin_amdgcn_mfma_f32_16x16x32_bf16(wf[2 * np][s], xf[s], a0, 0, 0, 0); a1 = __builtin_amdgcn_mfma_f32_16x16x32_bf16(wf[2 * np + 1][s], xf[s], a1, 0, 0, 0); }
            if constexpr (OUT8) { const f32x4 b0 = a0 * 8.f, b1 = a1 * 8.f; u32x2 w; w.x = pk4_fp8(b0.x, b0.y, b0.z, b0.w); w.y = pk4_fp8(b1.x, b1.y, b1.z, b1.w);
                *(u32x2*)((unsigned char*)OUT + ((size_t)t16 * 16 + fr) * ldo + 8 * fq + 32 * np) = w; }
            else st8(op + 32 * np, a0, a1);
        }
    }
}

struct EpiG {
    static constexpr bool PERM = true; static constexpr int MID_T = 0;
    const float* b_gate; unsigned char* G; bf16 *BQ, *BK, *BV, *KV, *AQ; const f32x2* R16;
    __device__ __forceinline__ void operator()(const f32x4 (&acc)[2][1][4][2], const gp::U& u, int wr, int wc, int fr, int fq) const {
        const int pn = u.c0, row0 = u.r0 + wr * 64 + fr, c8 = 32 * wc + 8 * fq;
        if (pn < 16) {
            const int gc0 = pn * 128 + c8;
            f32x4 bg[2];
#pragma unroll
            for (int n = 0; n < 2; ++n) bg[n] = *(const f32x4*)(b_gate + gc0 + 4 * n);
            asm volatile("" : "+v"(bg[0]), "+v"(bg[1]));
#pragma unroll
            for (int gi = 0; gi < 8; ++gi) { const int ai = gi >> 2, m = gi & 3; const int row = row0 + ai * 128 + m * 16; u32x2 pk; unsigned pw[2];
#pragma unroll
                for (int n = 0; n < 2; ++n) { f32x4 v = acc[ai][0][m][n] + bg[n];
                    v.x = __builtin_amdgcn_rcpf(1.f + __expf(-v.x)); v.y = __builtin_amdgcn_rcpf(1.f + __expf(-v.y)); v.z = __builtin_amdgcn_rcpf(1.f + __expf(-v.z)); v.w = __builtin_amdgcn_rcpf(1.f + __expf(-v.w));
                    pw[n] = pk4_fp8(fmaxf(v.x, 0.001953125f), fmaxf(v.y, 0.001953125f), fmaxf(v.z, 0.001953125f), fmaxf(v.w, 0.001953125f)); }
                pk.x = pw[0]; pk.y = pw[1];
                *(u32x2*)(G + (size_t)row * 2048 + gc0) = pk; }
        } else if (pn < 28) {
            const bool isk = pn >= 22, rp = (wc & 1) == 0 && fq < 2; const float qs = isk ? 1.f : 0.125f;
            bf16* dst0 = (isk ? BK + (pn - 22) * 128 : BQ + (pn - 16) * 128) + c8;
            f32x4 ca[2], cb[2]; ca[0] = *(const f32x4*)(R16 + (size_t)row0 * 8 + 4 * (fq & 1)); cb[0] = *(const f32x4*)(R16 + (size_t)row0 * 8 + 4 * (fq & 1) + 2);
#pragma unroll
            for (int gi = 0; gi < 8; ++gi) { const int ai = gi >> 2, m = gi & 3; const int row = row0 + ai * 128 + m * 16;
                if (gi < 7) { const int rn = row0 + ((gi + 1) >> 2) * 128 + ((gi + 1) & 3) * 16; ca[(gi + 1) & 1] = *(const f32x4*)(R16 + (size_t)rn * 8 + 4 * (fq & 1)); cb[(gi + 1) & 1] = *(const f32x4*)(R16 + (size_t)rn * 8 + 4 * (fq & 1) + 2); }
                asm volatile("" ::: "memory");
                f32x4 v0 = acc[ai][0][m][0] * qs, v1 = acc[ai][0][m][1] * qs; if (rp) { v0 = rope4(v0, ca[gi & 1]); v1 = rope4(v1, cb[gi & 1]); }
                if (isk) { u32x2 w; w.x = pk4_fp8(v0.x, v0.y, v0.z, v0.w); w.y = pk4_fp8(v1.x, v1.y, v1.z, v1.w);
                    *(u32x2*)((unsigned char*)BK + (size_t)row * 768 + (pn - 22) * 128 + (wc >> 1) * 64 + 16 * fq + 8 * (wc & 1)) = w; }
                else st8(dst0 + (size_t)row * 768, v0, v1); }
        } else if (pn < 34) {
#pragma unroll
            for (int gi = 0; gi < 8; ++gi) { const int ai = gi >> 2, m = gi & 3; const int row = row0 + ai * 128 + m * 16;
                { const f32x4 v0 = acc[ai][0][m][0], v1 = acc[ai][0][m][1]; u32x2 w; w.x = pk4_fp8(v0.x, v0.y, v0.z, v0.w); w.y = pk4_fp8(v1.x, v1.y, v1.z, v1.w);
                  *(u32x2*)((unsigned char*)BV + (size_t)row * 768 + (pn - 28) * 128 + c8) = w; } }
        } else if (pn < 36) {
#pragma unroll
            for (int gi = 0; gi < 8; ++gi) { const int ai = gi >> 2, m = gi & 3; const int row = row0 + ai * 128 + m * 16; const f32x4 v0 = acc[ai][0][m][0], v1 = acc[ai][0][m][1];
                float ss = (v0.x * v0.x + v0.y * v0.y + v0.z * v0.z + v0.w * v0.w) + (v1.x * v1.x + v1.y * v1.y + v1.z * v1.z + v1.w * v1.w);
                st8(KV + (size_t)row * KVS + (pn - 34) * 128 + c8, v0, v1);
                ss += __shfl_xor(ss, 16); ss += __shfl_xor(ss, 32);
                if (fq == 0) ((float*)(KV + (size_t)row * KVS + 272))[4 * (pn - 34) + wc] = ss; }
        } else {
            const bool rp = (wc & 1) == 0 && fq < 2;
            bf16* dst0 = AQ + (pn - 36) * 128 + c8;
            f32x4 ca[2], cb[2]; ca[0] = *(const f32x4*)(R16 + (size_t)row0 * 8 + 4 * (fq & 1)); cb[0] = *(const f32x4*)(R16 + (size_t)row0 * 8 + 4 * (fq & 1) + 2);
#pragma unroll
            for (int gi = 0; gi < 8; ++gi) { const int ai = gi >> 2, m = gi & 3; const int row = row0 + ai * 128 + m * 16;
                if (gi < 7) { const int rn = row0 + ((gi + 1) >> 2) * 128 + ((gi + 1) & 3) * 16; ca[(gi + 1) & 1] = *(const f32x4*)(R16 + (size_t)rn * 8 + 4 * (fq & 1)); cb[(gi + 1) & 1] = *(const f32x4*)(R16 + (size_t)rn * 8 + 4 * (fq & 1) + 2); }
                asm volatile("" ::: "memory");
                f32x4 v0 = acc[ai][0][m][0] * 0.125f, v1 = acc[ai][0][m][1] * 0.125f; if (rp) { v0 = rope4(v0, ca[gi & 1]); v1 = rope4(v1, cb[gi & 1]); }
                st8(dst0 + (size_t)row * 512, v0, v1); }
        }
    }
};
struct EpiUV {
    static constexpr bool PERM = true; static constexpr int MID_T = 8;
    const unsigned char* G; bf16* MP;
    __device__ __forceinline__ void mid(f32x4 (&acc)[2][2][4][2], const gp::U& u, int wr, int wc, int fr, int fq) const {
        unsigned off = (unsigned)((u.r0 + wr * 64 + fr) * 2048 + u.c0 * 256 + wc * 32 + 8 * fq);
        asm volatile("" : "+v"(off));
#pragma unroll
        for (int bt = 0; bt < 4; ++bt) { u32x2 ga[4], gb[4];
#pragma unroll
            for (int k = 0; k < 4; ++k) { const int i = 4 * bt + k, gi = i >> 1, bj = i & 1; const unsigned o = off + (unsigned)(((gi >> 2) * 128 + (gi & 3) * 16) * 2048 + bj * 128); ga[k] = *(const u32x2*)(G + o); gb[k] = *(const u32x2*)(G + (o + 1024u)); }
            asm volatile("" ::: "memory");
#pragma unroll
            for (int k = 0; k < 4; ++k) { const int i = 4 * bt + k, gi = i >> 1, bj = i & 1, ai = gi >> 2, m = gi & 3;
                const f32x4 b0 = up4_fp8(gb[k].x), b1 = up4_fp8(gb[k].y);
                acc[ai][bj][m][0] = acc[ai][bj][m][0] * (up4_fp8(ga[k].x) * (f32x4){__builtin_amdgcn_rcpf(b0.x), __builtin_amdgcn_rcpf(b0.y), __builtin_amdgcn_rcpf(b0.z), __builtin_amdgcn_rcpf(b0.w)});
                acc[ai][bj][m][1] = acc[ai][bj][m][1] * (up4_fp8(ga[k].y) * (f32x4){__builtin_amdgcn_rcpf(b1.x), __builtin_amdgcn_rcpf(b1.y), __builtin_amdgcn_rcpf(b1.z), __builtin_amdgcn_rcpf(b1.w)}); }
            __builtin_amdgcn_sched_barrier(0); }
    }
    __device__ __forceinline__ void operator()(const f32x4 (&acc)[2][2][4][2], const gp::U& u, int wr, int wc, int fr, int fq) const {
        const int row0 = u.r0 + wr * 64 + fr, col0 = u.c0 * 256 + wc * 32 + 8 * fq;
        u32x2 g[2][2];
#pragma unroll
        for (int bj = 0; bj < 2; ++bj) g[0][bj] = *(const u32x2*)(G + (size_t)row0 * 2048 + 1024 + col0 + bj * 128);
#pragma unroll
        for (int gi = 0; gi < 8; ++gi) { const int ai = gi >> 2, m = gi & 3; const size_t row = row0 + ai * 128 + m * 16;
            if (gi < 7) { const size_t rn = row0 + ((gi + 1) >> 2) * 128 + ((gi + 1) & 3) * 16;
#pragma unroll
                for (int bj = 0; bj < 2; ++bj) g[(gi + 1) & 1][bj] = *(const u32x2*)(G + rn * 2048 + 1024 + col0 + bj * 128); }
            asm volatile("" ::: "memory");
#pragma unroll
            for (int bj = 0; bj < 2; ++bj) { const u32x2 w = g[gi & 1][bj];
                st8(MP + row * DM + col0 + bj * 128, acc[ai][bj][m][0] * up4_fp8(w.x), acc[ai][bj][m][1] * up4_fp8(w.y)); } }
    }
};
struct EpiO {
    static constexpr bool PERM = false; static constexpr int MID_T = 0;
    const float* x; float* PRE;
    __device__ __forceinline__ void operator()(const f32x4 (&acc)[2][2][4][2], const gp::U& u, int wr, int wc, int fr, int fq) const {
        const int row0 = u.r0 + wr * 64 + fr, col0 = u.c0 * 256 + wc * 32 + 4 * fq;
        f32x4 xv[2][2][2];
#pragma unroll
        for (int bj = 0; bj < 2; ++bj)
#pragma unroll
            for (int n = 0; n < 2; ++n) xv[0][bj][n] = *(const f32x4*)(x + (size_t)row0 * DM + col0 + bj * 128 + n * 16);
#pragma unroll
        for (int gi = 0; gi < 8; ++gi) { const int ai = gi >> 2, m = gi & 3; const size_t row = row0 + ai * 128 + m * 16;
            if (gi < 7) { const size_t rn = row0 + ((gi + 1) >> 2) * 128 + ((gi + 1) & 3) * 16;
#pragma unroll
                for (int bj = 0; bj < 2; ++bj)
#pragma unroll
                    for (int n = 0; n < 2; ++n) xv[(gi + 1) & 1][bj][n] = *(const f32x4*)(x + rn * DM + col0 + bj * 128 + n * 16); }
            asm volatile("" ::: "memory");
#pragma unroll
            for (int bj = 0; bj < 2; ++bj)
#pragma unroll
                for (int n = 0; n < 2; ++n) *(f32x4*)(PRE + row * DM + col0 + bj * 128 + n * 16) = xv[gi & 1][bj][n] * ALPHA + acc[ai][bj][m][n]; }
    }
};

constexpr int YCAP_BLK = (int)((WS_HB - WS_Y) / (256 * 1024));
struct MoeTab { LAS int* pre; LAS int* cnt; };
__device__ __forceinline__ void moe_table(const Ptrs& P, MoeTab T) {
    if (threadIdx.x < 64) { const int e = threadIdx.x; const int c = (int)__hip_atomic_load(P.ctl + CW_CNT + 64 * e, __ATOMIC_RELAXED, __HIP_MEMORY_SCOPE_AGENT);
        const int blk = (c + 255) >> 8; int incl = blk;
#pragma unroll
        for (int o = 1; o < 64; o <<= 1) { const int t = __shfl_up(incl, o); incl += e >= o ? t : 0; }
        T.cnt[e] = c; T.pre[e] = incl - blk;
        if (e == 63) { T.cnt[64] = NTOK; T.pre[64] = incl; T.pre[65] = incl + NTOK / 256; } }
    __syncthreads();
}
struct MoeOrder1 {
    const unsigned char* H8; const unsigned char* W13; const int* LIST; MoeTab T; int G, c;
    __device__ __forceinline__ bool next(int i, gp::U& u) const {
        const int L0 = i * G + c; const int total = __builtin_amdgcn_readfirstlane(T.pre[65]) * 4; if (L0 >= total) return false;
        const int L = gp::xcd_chunk(L0, total);
        const int blk = L >> 2, j = L & 3; int e = 0;
        for (int q = 64; q >= 1; q >>= 1) if (e + q <= 64 && __builtin_amdgcn_readfirstlane(T.pre[e + q]) <= blk) e += q;
        const int rb = blk - __builtin_amdgcn_readfirstlane(T.pre[e]);
        u.A = (const char*)H8; u.B = (const char*)(W13 + ((size_t)e * 512 + j * 128) * DM);
        u.rows = e < 64 ? LIST + (size_t)e * NTOK + rb * 256 : nullptr; u.rbase = rb * 256; u.nvalid = min(256, __builtin_amdgcn_readfirstlane(T.cnt[e]) - rb * 256);
        u.r0 = blk * 256; u.c0 = j; u.x0 = e; u.x1 = rb;
        return true;
    }
};
struct EpiM1 {
    static constexpr bool PERM = true; static constexpr int MID_T = 0;
    bf16* HB; const float* WLIST;
    __device__ __forceinline__ void operator()(const f32x4 (&acc)[2][1][4][2], const gp::U& u, int wr, int wc, int fr, int fq) const {
        const int row0 = u.r0 + wr * 64 + fr, col0 = u.c0 * 64 + wc * 16 + 4 * fq;
        float w[8];
        if (u.x0 < 64) { const float* wl = WLIST + (size_t)u.x0 * NTOK + u.x1 * 256;
#pragma unroll
            for (int gi = 0; gi < 8; ++gi) { const int rl = wr * 64 + fr + (gi >> 2) * 128 + (gi & 3) * 16; w[gi] = wl[min(rl, u.nvalid - 1)]; } }
        else {
#pragma unroll
            for (int gi = 0; gi < 8; ++gi) w[gi] = 1.f; }
        asm volatile("" : "+v"(w[0]), "+v"(w[1]), "+v"(w[2]), "+v"(w[3]), "+v"(w[4]), "+v"(w[5]), "+v"(w[6]), "+v"(w[7]));
#pragma unroll
        for (int ai = 0; ai < 2; ++ai)
#pragma unroll
            for (int m = 0; m < 4; ++m) { const size_t row = row0 + ai * 128 + m * 16; const float ww = w[ai * 4 + m];
                const f32x4 a = acc[ai][0][m][0], b = acc[ai][0][m][1] * ww; f32x4 v;
                v.x = a.x * __builtin_amdgcn_rcpf(1.f + __expf(-a.x)) * b.x; v.y = a.y * __builtin_amdgcn_rcpf(1.f + __expf(-a.y)) * b.y;
                v.z = a.z * __builtin_amdgcn_rcpf(1.f + __expf(-a.z)) * b.z; v.w = a.w * __builtin_amdgcn_rcpf(1.f + __expf(-a.w)) * b.w;
                st4(HB + row * 256 + col0, v); }
    }
};
struct MoeOrder2 {
    const bf16* HB; const bf16* W2; MoeTab T; int G, c, e_lo, e_hi;
    __device__ __forceinline__ bool next(int i, gp::U& u) const {
        const int L = i * G + c; const int b0 = __builtin_amdgcn_readfirstlane(T.pre[e_lo]), total = (__builtin_amdgcn_readfirstlane(T.pre[e_hi]) - b0) * 4; if (L >= total) return false;
        const int blk = b0 + (L >> 2), jn = L & 3; int e = 0;
        for (int q = 64; q >= 1; q >>= 1) if (e + q <= 64 && __builtin_amdgcn_readfirstlane(T.pre[e + q]) <= blk) e += q;
        const int rb = blk - __builtin_amdgcn_readfirstlane(T.pre[e]);
        u.A = (const char*)(HB + (size_t)blk * 256 * 256); u.B = (const char*)(W2 + ((size_t)e * 1024 + jn * 256) * 256);
        u.rows = nullptr; u.rbase = 0; u.nvalid = min(256, __builtin_amdgcn_readfirstlane(T.cnt[e]) - rb * 256);
        u.r0 = (blk - b0) * 256; u.c0 = jn; u.x0 = e; u.x1 = rb;
        return true;
    }
};
constexpr int LDS_XCH = 139264;
struct EpiM2R {
    static constexpr bool PERM = true; static constexpr int MID_T = 0;
    unsigned char* Y; const float* WLIST; LAS unsigned char* lds;
    __device__ __forceinline__ void operator()(const f32x4 (&acc)[2][2][4][2], const gp::U& u, int wr, int wc, int fr, int fq) const {
        const int lane = fr + 16 * fq;
        const int wch = 4 * wc + fq;
        LAS unsigned char* wp0 = lds + LDS_XCH + wr * 4096 + fr * 256 + ((((wch) >> 1) ^ fr) << 4) + ((wch & 1) << 3);
        LAS unsigned char* wp1 = lds + LDS_XCH + wr * 4096 + fr * 256 + ((((16 + wch) >> 1) ^ fr) << 4) + ((wch & 1) << 3);
        const int rr = 4 * wc + (lane >> 4), rch = lane & 15;
        const LAS unsigned char* rp = lds + LDS_XCH + wr * 4096 + rr * 256 + ((rch ^ rr) << 4);
        unsigned char* ybase = Y + (size_t)(u.r0 + wr * 64 + rr) * DM + u.c0 * 256 + 16 * rch;
#pragma unroll
        for (int gi = 0; gi < 8; ++gi) { const int ai = gi >> 2, m = gi & 3;
            { const f32x4 a = acc[ai][0][m][0] * YSCALE, b = acc[ai][0][m][1] * YSCALE; u32x2 pk; pk.x = pk4_fp8(a.x, a.y, a.z, a.w); pk.y = pk4_fp8(b.x, b.y, b.z, b.w); *(LAS u32x2*)(wp0 + (gi & 1) * 8192) = pk; }
            { const f32x4 a = acc[ai][1][m][0] * YSCALE, b = acc[ai][1][m][1] * YSCALE; u32x2 pk; pk.x = pk4_fp8(a.x, a.y, a.z, a.w); pk.y = pk4_fp8(b.x, b.y, b.z, b.w); *(LAS u32x2*)(wp1 + (gi & 1) * 8192) = pk; }
            LDS_WAIT(); __builtin_amdgcn_s_barrier(); asm volatile("" ::: "memory");
            const u32x4 o = *(const LAS u32x4*)(rp + (gi & 1) * 8192);
            const int rl = wr * 64 + ai * 128 + m * 16 + rr;
            if (rl < u.nvalid) __builtin_nontemporal_store(o, (u32x4*)(ybase + (size_t)(ai * 128 + m * 16) * DM)); }
    }
};
struct EpiM2S {
    static constexpr bool PERM = false; static constexpr int MID_T = 0;
    float* ACC;
    __device__ __forceinline__ void operator()(const f32x4 (&acc)[2][2][4][2], const gp::U& u, int wr, int wc, int fr, int fq) const {
        const int row0 = u.x1 * 256 + wr * 64 + fr, col0 = u.c0 * 256 + wc * 32 + 4 * fq;
        f32x4 xv[2][2][2];
#pragma unroll
        for (int bj = 0; bj < 2; ++bj)
#pragma unroll
            for (int n = 0; n < 2; ++n) xv[0][bj][n] = *(const f32x4*)(ACC + (size_t)row0 * DM + col0 + bj * 128 + n * 16);
#pragma unroll
        for (int gi = 0; gi < 8; ++gi) { const int ai = gi >> 2, m = gi & 3; const size_t row = row0 + ai * 128 + m * 16;
            if (gi < 7) { const size_t rn = row0 + ((gi + 1) >> 2) * 128 + ((gi + 1) & 3) * 16;
#pragma unroll
                for (int bj = 0; bj < 2; ++bj)
#pragma unroll
                    for (int n = 0; n < 2; ++n) xv[(gi + 1) & 1][bj][n] = *(const f32x4*)(ACC + rn * DM + col0 + bj * 128 + n * 16); }
            asm volatile("" ::: "memory");
#pragma unroll
            for (int bj = 0; bj < 2; ++bj)
#pragma unroll
                for (int n = 0; n < 2; ++n) *(f32x4*)(ACC + row * DM + col0 + bj * 128 + n * 16) = xv[gi & 1][bj][n] + acc[ai][bj][m][n]; }
    }
};

__device__ __forceinline__ void expert_weights(const Ptrs& P, LAS unsigned char* lds, int gw, int NGW, int wave, int lane) {
    LAS float* scr = (LAS float*)(lds + wave * 16384);
    for (int it = gw; it < 65 * 256; it += NGW) { const int e = it >> 8, r = it & 255;
        const int which = r >> 7, q = r & 127, kb = q >> 3, cb = q & 7, c0 = cb * 32;
        const float* W = e < 64 ? (which ? P.w3_e : P.w1_e) + (size_t)e * DM * DEXP : (which ? P.ws3 : P.ws1);
        float v[32]; tr_load(W, DEXP, kb * 64, c0 + (lane & 31), v, lane); tr_finish(v, 1.f, P.W13 + (size_t)e * 512 * DM, DM, 256 * (c0 >> 7) + (c0 & 127) + which * 128, kb * 64, lane); }
}
__device__ __forceinline__ void expert_weights_w2(const Ptrs& P, LAS unsigned char* lds, int wave, int lane) {
    LAS float* scr = (LAS float*)(lds + wave * 16384); LAS int* slot = (LAS int*)(lds + 135168 + 1024);
#pragma nounroll
    for (;;) {
        if (threadIdx.x == 0) *slot = (int)__hip_atomic_fetch_add(P.ctl + CW_W2Q, 8u, __ATOMIC_RELAXED, __HIP_MEMORY_SCOPE_AGENT);
        __syncthreads();
        const int it = *slot + wave;
        __syncthreads();
        if (it - wave >= 65 * 128) break;
        const int e = it >> 7, q = it & 127, kb = q >> 5, nb = q & 31;
        const float* W = e < 64 ? P.w2_e + (size_t)e * DEXP * DM : P.ws2;
        float v[32]; tr_load(W, DM, kb * 64, nb * 32 + (lane & 31), v, lane); tr_finish(v, 1.f, P.W2 + (size_t)e * DM * DEXP, DEXP, nb * 32, kb * 64, lane); }
}

__device__ __forceinline__ void w13_load(const Ptrs& P, int it, float (&v)[32], int lane) {
    const int e = it >> 8, r = it & 255, which = r >> 7, q = r & 127, kb = q >> 3, c0 = (q & 7) * 32;
    const float* W = e < 64 ? (which ? P.w3_e : P.w1_e) + (size_t)e * DM * DEXP : (which ? P.ws3 : P.ws1);
    tr_load(W, DEXP, kb * 64, c0 + (lane & 31), v, lane);
}
__device__ __forceinline__ void w13_finish(const Ptrs& P, int it, const float (&v)[32], int lane) {
    const int e = it >> 8, r = it & 255, which = r >> 7, q = r & 127, kb = q >> 3, sc = (q & 7) * 32 + (lane & 31);
    tr_finish8(v, 64.f, (unsigned char*)P.W13, DM, 0, kb * 64, lane, e * 512 + 128 * (sc >> 6) + 8 * ((sc & 63) >> 2) + 4 * which + (sc & 3));
}
constexpr int L1_HT = 0, L1_PART = 66048, L1_RTOK = 98816, L1_RER = 102912, L1_RW = 107008, L1_LCNT = 111104, L1_BASE = 111360;
__device__ __forceinline__ void ln1_router_phase(const Ptrs& P, LAS unsigned char* lds, int vcu, int G, int gw, int NGW, int wave, int lane) {
    LAS float* hT = (LAS float*)(lds + L1_HT); LAS float* PART = (LAS float*)(lds + L1_PART);
    LAS int* rtok = (LAS int*)(lds + L1_RTOK); LAS int* rer = (LAS int*)(lds + L1_RER); LAS float* rw = (LAS float*)(lds + L1_RW);
    LAS int* lcnt = (LAS int*)(lds + L1_LCNT); LAS int* base = (LAS int*)(lds + L1_BASE);
    const int tid = threadIdx.x;
    if (tid < 64) lcnt[tid] = 0;
    __syncthreads();
    int nrec = 0;
    const int ngroups = NTOK / 16;
    int gi = 0;
    f32x4 nv[2][4];
#pragma unroll
    for (int rr = 0; rr < 2; ++rr)
#pragma unroll
        for (int j = 0; j < 4; ++j) nv[rr][j] = *((const f32x4*)(P.out + ((size_t)min(vcu, ngroups - 1) * 16 + 2 * wave + rr) * DM) + lane + 64 * j);
    float cw[32];
    const float rbias = P.router_bias[lane];
    for (int grp = vcu; grp < ngroups; grp += G, ++gi) {
        const int cit = gw + gi * NGW; const bool chas = cit < 65 * 256;
#pragma unroll
        for (int rr = 0; rr < 2; ++rr) {
            const int rloc = 2 * wave + rr; const size_t row = (size_t)grp * 16 + rloc;
            f32x4 v[4]; float s = 0.f;
#pragma unroll
            for (int j = 0; j < 4; ++j) { v[j] = nv[rr][j]; s += (v[j].x + v[j].y) + (v[j].z + v[j].w); }
            const float mean = wave_sum(s) * (1.f / DM); float s2 = 0.f;
#pragma unroll
            for (int j = 0; j < 4; ++j) { v[j] = v[j] - mean; s2 += (v[j].x * v[j].x + v[j].y * v[j].y) + (v[j].z * v[j].z + v[j].w * v[j].w); }
            const float rstd = 1.f / sqrtf(wave_sum(s2) * (1.f / DM) + LN_EPS);
#pragma unroll
            for (int j = 0; j < 4; ++j) { const int c = 4 * lane + 256 * j; const f32x4 g = *(const f32x4*)(P.ln1_g + c), b = *(const f32x4*)(P.ln1_b + c);
                const f32x4 h = v[j] * rstd * g + b;
                st4(P.HBF + row * (2 * DM) + c, h);
                *(unsigned*)((unsigned char*)P.out + row * (4 * DM) + 2 * DM + c) = pk4_fp8(h.x, h.y, h.z, h.w);
                *(LAS f32x4*)(hT + rloc * 1028 + c) = h; }
        }
        { const int gn = grp + G < ngroups ? grp + G : grp;
#pragma unroll
          for (int rr = 0; rr < 2; ++rr)
#pragma unroll
              for (int j = 0; j < 4; ++j) nv[rr][j] = *((const f32x4*)(P.out + ((size_t)gn * 16 + 2 * wave + rr) * DM) + lane + 64 * j); }
        __syncthreads();
        if (gi > 0 && cit - NGW < 65 * 256) w13_finish(P, cit - NGW, cw, lane);
        f32x4 z[4] = {(f32x4){0.f, 0.f, 0.f, 0.f}, (f32x4){0.f, 0.f, 0.f, 0.f}, (f32x4){0.f, 0.f, 0.f, 0.f}, (f32x4){0.f, 0.f, 0.f, 0.f}};
        {
            const int fr = lane & 15, fq = lane >> 4;
            const LAS float* ap = hT + fr * 1028 + 128 * wave + fq;
            const float* bp = P.w_router + (size_t)(128 * wave + fq) * 64 + fr;
#pragma unroll 4
            for (int s = 0; s < 32; ++s) { const float a = ap[4 * s];
#pragma unroll
                for (int jt = 0; jt < 4; ++jt) z[jt] = __builtin_amdgcn_mfma_f32_16x16x4f32(a, bp[(size_t)(4 * s) * 64 + 16 * jt], z[jt], 0, 0, 0); }
#pragma unroll
            for (int jt = 0; jt < 4; ++jt)
#pragma unroll
                for (int jj = 0; jj < 4; ++jj) PART[(wave * 16 + 4 * fq + jj) * 64 + 16 * jt + fr] = z[jt][jj];
        }
        if (chas) w13_load(P, cit, cw, lane);
        __syncthreads();
#pragma unroll
        for (int rr = 0; rr < 2; ++rr) {
            const int rloc = 2 * wave + rr; const int tok = grp * 16 + rloc;
            float logit = 0.f;
#pragma unroll
            for (int w2 = 0; w2 < 8; ++w2) logit += PART[(w2 * 16 + rloc) * 64 + lane];
            const float score = 1.f / (1.f + expf(-logit));
            const float biased = score + rbias;
            float m1 = biased;
#pragma unroll
            for (int o = 1; o < 8; o <<= 1) m1 = fmaxf(m1, __shfl_xor(m1, o));
            const unsigned long long is1 = __ballot(biased == m1);
            const int gbase = lane & ~7; const unsigned gm = (unsigned)((is1 >> gbase) & 0xffull);
            const int first = gbase + __builtin_ctz(gm);
            float m2 = lane == first ? -INFINITY : biased;
#pragma unroll
            for (int o = 1; o < 8; o <<= 1) m2 = fmaxf(m2, __shfl_xor(m2, o));
            const float gs = m1 + m2;
            int grank = 0; const int mygrp = lane >> 3;
#pragma unroll
            for (int g2 = 0; g2 < 8; ++g2) { const float o = __shfl(gs, 8 * g2); grank += (o > gs || (o == gs && g2 < mygrp)) ? 1 : 0; }
            const float mv = grank < 4 ? biased : -INFINITY;
            int rank = 0;
            { LAS float* mvs = PART + (wave * 2 + rr) * 64;
              LDS_WAIT(); mvs[lane] = mv; LDS_WAIT();
#pragma unroll
              for (int l4 = 0; l4 < 16; ++l4) { const f32x4 o = *(const LAS f32x4*)(mvs + 4 * l4);
                  rank += (o.x > mv || (o.x == mv && 4 * l4 < lane)) ? 1 : 0; rank += (o.y > mv || (o.y == mv && 4 * l4 + 1 < lane)) ? 1 : 0;
                  rank += (o.z > mv || (o.z == mv && 4 * l4 + 2 < lane)) ? 1 : 0; rank += (o.w > mv || (o.w == mv && 4 * l4 + 3 < lane)) ? 1 : 0; } }
            const bool sel = rank < 8;
            const float ssum = wave_sum(sel ? score : 0.f);
            const float w = score / ssum * 2.5f;
            const unsigned long long selm = __ballot(sel);
            if (sel) { const int k = __popcll(selm & ((1ull << lane) - 1ull));
                const int lr = __hip_atomic_fetch_add(&lcnt[lane], 1, __ATOMIC_RELAXED, __HIP_MEMORY_SCOPE_WORKGROUP);
                const int ri = (gi * 16 + rloc) * 8 + k;
                rtok[ri] = tok * 8 + k; rer[ri] = (lane << 16) | lr; rw[ri] = w; }
        }
        __syncthreads();
    }
    if (gi > 0 && gw + (gi - 1) * NGW < 65 * 256) w13_finish(P, gw + (gi - 1) * NGW, cw, lane);
    for (int cit = gw + gi * NGW; cit < 65 * 256; cit += NGW) { w13_load(P, cit, cw, lane); w13_finish(P, cit, cw, lane); }
    (void)nrec;
    if (tid < 64) base[tid] = (int)__hip_atomic_fetch_add(P.ctl + CW_CNT + 64 * tid, (unsigned)lcnt[tid], __ATOMIC_RELAXED, __HIP_MEMORY_SCOPE_AGENT);
    __syncthreads();
    const int nr = gi * 128;
    for (int i = tid; i < nr; i += NWAVES * 64) { const int tk = rtok[i], er = rer[i], e = er >> 16, pos = base[e] + (er & 0xffff);
        P.LIST[(size_t)e * NTOK + pos] = tk >> 3; P.WLIST[(size_t)e * NTOK + pos] = rw[i]; P.REC[tk] = (unsigned)((e << 16) | pos); }
    __syncthreads();
}

template <bool FINAL>
__device__ __forceinline__ void combine_phase(const Ptrs& P, MoeTab T, int e_lo, int e_hi, int gw, int NGW, int lane) {
    const int b0 = T.pre[e_lo], q = lane >> 4, l16 = lane & 15;
#pragma nounroll
    for (int t0 = gw * 4; t0 < NTOK; t0 += NGW * 4) {
        const int tok = t0 + q;
        float* orow = P.out + (size_t)tok * DM + 8 * l16;
        f32x4 v[8][2];
#pragma unroll
        for (int j = 0; j < 8; ++j) { ld8bf(P.HBF + (size_t)tok * (2 * DM) + 8 * l16 + 128 * j, v[j][0], v[j][1]); v[j][0] = v[j][0] * ALPHA; v[j][1] = v[j][1] * ALPHA; }
        const unsigned rec = P.REC[tok * 8 + (lane & 7)];
#pragma unroll
        for (int k = 0; k < 8; ++k) { const unsigned r = __shfl(rec, (lane & 48) + k); const int e = (int)(r >> 16), pos = (int)(r & 0xffffu);
            if (e >= e_lo && e < e_hi) { const unsigned char* y = (const unsigned char*)P.Y + ((size_t)(T.pre[e] - b0) * 256 + pos) * DM + 8 * l16;
#pragma unroll
                for (int j = 0; j < 8; ++j) { const u32x2 w = *(const u32x2*)(y + 128 * j); v[j][0] = v[j][0] + up4_fp8(w.x) * (1.f / YSCALE); v[j][1] = v[j][1] + up4_fp8(w.y) * (1.f / YSCALE); } } }
        { const unsigned char* y = (const unsigned char*)P.Y + ((size_t)(T.pre[64] - b0) * 256 + tok) * DM + 8 * l16;
#pragma unroll
          for (int j = 0; j < 8; ++j) { const u32x2 w = *(const u32x2*)(y + 128 * j); v[j][0] = v[j][0] + up4_fp8(w.x) * (1.f / YSCALE); v[j][1] = v[j][1] + up4_fp8(w.y) * (1.f / YSCALE); } }
        if (FINAL) {
            float s = 0.f;
#pragma unroll
            for (int j = 0; j < 8; ++j) s += ((v[j][0].x + v[j][0].y) + (v[j][0].z + v[j][0].w)) + ((v[j][1].x + v[j][1].y) + (v[j][1].z + v[j][1].w));
#pragma unroll
            for (int o = 1; o < 16; o <<= 1) s += __shfl_xor(s, o);
            const float mean = s * (1.f / DM); float s2 = 0.f;
#pragma unroll
            for (int j = 0; j < 8; ++j) { v[j][0] = v[j][0] - mean; v[j][1] = v[j][1] - mean;
                s2 += ((v[j][0].x * v[j][0].x + v[j][0].y * v[j][0].y) + (v[j][0].z * v[j][0].z + v[j][0].w * v[j][0].w)) + ((v[j][1].x * v[j][1].x + v[j][1].y * v[j][1].y) + (v[j][1].z * v[j][1].z + v[j][1].w * v[j][1].w)); }
#pragma unroll
            for (int o = 1; o < 16; o <<= 1) s2 += __shfl_xor(s2, o);
            const float rstd = 1.f / sqrtf(s2 * (1.f / DM) + LN_EPS);
#pragma unroll
            for (int j = 0; j < 8; ++j) { const int c = 8 * l16 + 128 * j;
                v[j][0] = v[j][0] * rstd * *(const f32x4*)(P.ln2_g + c) + *(const f32x4*)(P.ln2_b + c); v[j][1] = v[j][1] * rstd * *(const f32x4*)(P.ln2_g + c + 4) + *(const f32x4*)(P.ln2_b + c + 4); }
        }
#pragma unroll
        for (int j = 0; j < 8; ++j) { *(f32x4*)(orow + 128 * j) = v[j][0]; *(f32x4*)(orow + 128 * j + 4) = v[j][1]; }
    }
}

constexpr int VST = 144;
__device__ __forceinline__ void mixb_item(const Ptrs& P, LAS unsigned char* wl, int b, int tb, int c, int j, int lane) {
    const int fr = lane & 15, fq = lane >> 4;
    const int t0 = tb * 256 + c; const size_t rowb = (size_t)b * SEQ;
    const int tq = t0 + 16 * fr;
    float m = -INFINITY, lsum = 0.f;
    f32x4 O[4] = {(f32x4){0.f, 0.f, 0.f, 0.f}, (f32x4){0.f, 0.f, 0.f, 0.f}, (f32x4){0.f, 0.f, 0.f, 0.f}, (f32x4){0.f, 0.f, 0.f, 0.f}};
    const unsigned tr_base = (unsigned)(size_t)wl + (unsigned)((4 * fq + (fr >> 2)) * VST + (fr & 3) * 8);
#pragma nounroll
    for (int g = 0; g < 3; ++g) {
        const int d = g == 0 ? 1 : (g == 1 ? 4 : 16), sq = 16 / d, hh = 4 * g + j;
        const int NP = (((129 + 15 * sq + 15) >> 4) + 1) >> 1;
        const bf16* qp = P.BQ + (rowb + tq) * 768 + hh * 64 + 8 * fq;
        const bf16x8 q0 = *(const bf16x8*)qp, q1 = *(const bf16x8*)(qp + 32);
        const int relq = fr * sq;
        const char* kb = (const char*)P.BK + rowb * 768 + hh * 64; const char* vb = (const char*)P.BV + rowb * 768 + hh * 64;
        const unsigned klane = 16u * fq, vlane = 16u * (lane & 3);
        u32x4 kra, krb; u32x4 v0, v1;
#define MIXB_LOAD(r0) do { \
        const int kpa = min(max(t0 + d * ((r0) + fr), 0), SEQ - 1), kpb = min(max(t0 + d * ((r0) + 16 + fr), 0), SEQ - 1); \
        kra = *(const u32x4*)(kb + (unsigned)kpa * 768u + klane); krb = *(const u32x4*)(kb + (unsigned)kpb * 768u + klane); \
        const int p0 = min(max(t0 + d * ((r0) + (lane >> 2)), 0), SEQ - 1), p1 = min(max(t0 + d * ((r0) + 16 + (lane >> 2)), 0), SEQ - 1); \
        v0 = *(const u32x4*)(vb + (unsigned)p0 * 768u + vlane); v1 = *(const u32x4*)(vb + (unsigned)p1 * 768u + vlane); } while (0)
        MIXB_LOAD(-128);
#pragma nounroll
        for (int tp = 0; tp < NP; ++tp) {
#define MIXB_V8(w0, w1) ([&]() { const f32x4 a_ = up4_fp8(w0), b_ = up4_fp8(w1); u32x4 p_; p_.x = cvt_pk_bf16(a_.x, a_.y); p_.y = cvt_pk_bf16(a_.z, a_.w); p_.z = cvt_pk_bf16(b_.x, b_.y); p_.w = cvt_pk_bf16(b_.z, b_.w); return p_; }())
            { LAS unsigned char* vw = wl + (lane >> 2) * VST + (lane & 3) * 32;
              *(LAS u32x4*)vw = MIXB_V8(v0.x, v0.y); *(LAS u32x4*)(vw + 16) = MIXB_V8(v0.z, v0.w);
              *(LAS u32x4*)(vw + 16 * VST) = MIXB_V8(v1.x, v1.y); *(LAS u32x4*)(vw + 16 * VST + 16) = MIXB_V8(v1.z, v1.w); }
#undef MIXB_V8
            f32x4 sa = (f32x4){0.f, 0.f, 0.f, 0.f}, sb = (f32x4){0.f, 0.f, 0.f, 0.f};
#define MIXB_K8(lo, hi) ([&]() { const f32x4 a_ = up4_fp8(lo), b_ = up4_fp8(hi); u32x4 p_; p_.x = cvt_pk_bf16(a_.x, a_.y); p_.y = cvt_pk_bf16(a_.z, a_.w); p_.z = cvt_pk_bf16(b_.x, b_.y); p_.w = cvt_pk_bf16(b_.z, b_.w); return __builtin_bit_cast(bf16x8, p_); }())
            { const bf16x8 ka0 = MIXB_K8(kra.x, kra.y), ka1 = MIXB_K8(kra.z, kra.w), kb0 = MIXB_K8(krb.x, krb.y), kb1 = MIXB_K8(krb.z, krb.w);
              sa = __builtin_amdgcn_mfma_f32_16x16x32_bf16(ka0, q0, sa, 0, 0, 0); sb = __builtin_amdgcn_mfma_f32_16x16x32_bf16(kb0, q0, sb, 0, 0, 0);
              sa = __builtin_amdgcn_mfma_f32_16x16x32_bf16(ka1, q1, sa, 0, 0, 0); sb = __builtin_amdgcn_mfma_f32_16x16x32_bf16(kb1, q1, sb, 0, 0, 0); }
#undef MIXB_K8
            { const int rn = -128 + 32 * min(tp + 1, NP - 1); MIXB_LOAD(rn); }
            const int relk0 = -128 + 32 * tp + 4 * fq;
            float sv[8] = {sa.x, sa.y, sa.z, sa.w, sb.x, sb.y, sb.z, sb.w};
#pragma unroll
            for (int jj = 0; jj < 8; ++jj) { const int relk = relk0 + (jj & 3) + 16 * (jj >> 2), dlt = relq - relk; const bool ok = dlt >= 0 && dlt <= 128 && (t0 + d * relk) >= 0; sv[jj] = ok ? sv[jj] : -INFINITY; }
            float tmax = fmaxf(fmaxf(fmaxf(sv[0], sv[1]), fmaxf(sv[2], sv[3])), fmaxf(fmaxf(sv[4], sv[5]), fmaxf(sv[6], sv[7])));
            { const auto r = __builtin_amdgcn_permlane16_swap(__float_as_uint(tmax), __float_as_uint(tmax), false, false); tmax = fmaxf(__uint_as_float(r[0]), __uint_as_float(r[1]));
              const auto q = __builtin_amdgcn_permlane32_swap(__float_as_uint(tmax), __float_as_uint(tmax), false, false); tmax = fmaxf(__uint_as_float(q[0]), __uint_as_float(q[1])); }
            const float mn = fmaxf(m, tmax), mu = mn == -INFINITY ? 0.f : mn;
            const float alpha = __expf(m - mu);
            float p[8];
#pragma unroll
            for (int jj = 0; jj < 8; ++jj) p[jj] = __expf(sv[jj] - mu);
            lsum = lsum * alpha + (((p[0] + p[1]) + (p[2] + p[3])) + ((p[4] + p[5]) + (p[6] + p[7])));
            m = mn;
#pragma unroll
            for (int cc = 0; cc < 4; ++cc) O[cc] = O[cc] * alpha;
            u32x4 pw; pw.x = cvt_pk_bf16(p[0], p[1]); pw.y = cvt_pk_bf16(p[2], p[3]); pw.z = cvt_pk_bf16(p[4], p[5]); pw.w = cvt_pk_bf16(p[6], p[7]);
            const bf16x8 pb = __builtin_bit_cast(bf16x8, pw);
            u32x2 a0, a1, a2, a3, b0, b1, b2, b3;
            asm volatile("s_waitcnt lgkmcnt(0)\n\tds_read_b64_tr_b16 %0, %8\n\tds_read_b64_tr_b16 %1, %8 offset:32\n\tds_read_b64_tr_b16 %2, %8 offset:64\n\tds_read_b64_tr_b16 %3, %8 offset:96\n\t"
                         "ds_read_b64_tr_b16 %4, %8 offset:2304\n\tds_read_b64_tr_b16 %5, %8 offset:2336\n\tds_read_b64_tr_b16 %6, %8 offset:2368\n\tds_read_b64_tr_b16 %7, %8 offset:2400\n\ts_waitcnt lgkmcnt(0)"
                         : "=&v"(a0), "=&v"(a1), "=&v"(a2), "=&v"(a3), "=&v"(b0), "=&v"(b1), "=&v"(b2), "=&v"(b3) : "v"(tr_base) : "memory");
#define MIXB_PV(c, AA, BB) { u32x4 vv; vv.x = AA.x; vv.y = AA.y; vv.z = BB.x; vv.w = BB.y; O[c] = __builtin_amdgcn_mfma_f32_16x16x32_bf16(__builtin_bit_cast(bf16x8, vv), pb, O[c], 0, 0, 0); }
            MIXB_PV(0, a0, b0) MIXB_PV(1, a1, b1) MIXB_PV(2, a2, b2) MIXB_PV(3, a3, b3)
#undef MIXB_PV
        }
#undef MIXB_LOAD
    }
    float lt = lsum; lt += __shfl_xor(lt, 16); lt += __shfl_xor(lt, 32);
    const float inv = 1.f / lt;
    bf16* op = P.AB + (rowb + tq) * 768 + 512 + j * 64 + 4 * fq;
#pragma unroll
    for (int cc = 0; cc < 4; ++cc) st4(op + 16 * cc, O[cc] * inv);
}

constexpr int MIX_WAVE_LDS = 20224;
constexpr int CAP = 1280;
constexpr int MA_AVAL = 0, MA_AIDX = 5120, MA_BVAL = 7680, MA_BIDX = 12800, MA_HIST = 15360, MA_SIDE = 16384, MA_LIST = 19200;
constexpr int MA_TILE = 0, MA_TILEB = 9216;
__device__ __forceinline__ unsigned f2u(float f) { const unsigned b = __float_as_uint(f); return b ^ ((b >> 31) ? 0xFFFFFFFFu : 0x80000000u); }
__device__ __forceinline__ float u2f(unsigned u) { const unsigned b = (u >> 31) ? (u ^ 0x80000000u) : ~u; return __uint_as_float(b); }
__device__ __forceinline__ unsigned wave_umax(unsigned v) {
#pragma unroll
    for (int o = 1; o < 64; o <<= 1) { const unsigned w = (unsigned)__shfl_xor((int)v, o); v = v > w ? v : w; }
    return v;
}
__device__ __forceinline__ float wave_max(float v) {
#pragma unroll
    for (int o = 1; o < 64; o <<= 1) v = fmaxf(v, __shfl_xor(v, o));
    return v;
}
__device__ __forceinline__ void hist_find(const LAS unsigned* hist, int need, int lane, int& bstar, int& above_out) {
    const u32x4 c = *(const LAS u32x4*)(hist + 4 * lane);
    const int s = (int)(c.x + c.y + c.z + c.w); int pre = s;
    pre += __builtin_amdgcn_update_dpp(0, pre, 0x111, 0xf, 0xf, true);
    pre += __builtin_amdgcn_update_dpp(0, pre, 0x112, 0xf, 0xf, true);
    pre += __builtin_amdgcn_update_dpp(0, pre, 0x114, 0xf, 0xf, true);
    pre += __builtin_amdgcn_update_dpp(0, pre, 0x118, 0xf, 0xf, true);
    const int R0 = __builtin_amdgcn_readlane(pre, 15), R1 = __builtin_amdgcn_readlane(pre, 31), R2 = __builtin_amdgcn_readlane(pre, 47), R3 = __builtin_amdgcn_readlane(pre, 63);
    const int row = lane >> 4; const int gpre = pre + (row >= 1 ? R0 : 0) + (row >= 2 ? R1 : 0) + (row >= 3 ? R2 : 0);
    const int above = (R0 + R1 + R2 + R3) - gpre, t = above + s;
    const bool hit = above < need && need <= t;
    const unsigned long long hm = __ballot(hit);
    const int L = hm ? (int)__builtin_ctzll(hm) : 0;
    int digit, cum = above;
    if (cum + (int)c.w >= need) digit = 3; else { cum += (int)c.w; if (cum + (int)c.z >= need) digit = 2; else { cum += (int)c.z; if (cum + (int)c.y >= need) digit = 1; else { cum += (int)c.y; digit = 0; } } }
    digit += 4 * lane;
    bstar = __builtin_amdgcn_readlane(digit, L); above_out = __builtin_amdgcn_readlane(cum, L);
}
__device__ __forceinline__ unsigned compact256(LAS unsigned* val, LAS unsigned short* idx, LAS unsigned* hist, int n, int lane) {
    unsigned prefix = 0u; int kk = 256;
    const int nch = (n + 63) >> 6;
    const unsigned long long ltm = (1ull << lane) - 1ull;
#pragma nounroll
    for (int pass = 0; pass < 4; ++pass) {
        const int shift = 24 - 8 * pass;
        *(LAS u32x4*)(hist + 4 * lane) = (u32x4){0u, 0u, 0u, 0u};
        LDS_WAIT();
#pragma nounroll
        for (int mc = 0; mc < nch; ++mc) { const int i = lane + 64 * mc;
            if (i < n) { const unsigned u = val[i]; const bool in = ((unsigned long long)u >> (shift + 8)) == (unsigned long long)prefix;
                if (in) __hip_atomic_fetch_add(&hist[(u >> shift) & 255u], 1u, __ATOMIC_RELAXED, __HIP_MEMORY_SCOPE_WAVEFRONT); } }
        LDS_WAIT();
        int digit, cum; hist_find(hist, kk, lane, digit, cum);
        kk -= cum; prefix = (prefix << 8) | (unsigned)digit;
    }
    const unsigned T = prefix; int outp = 0, eqc = 0;
#pragma nounroll
    for (int mc = 0; mc < nch; ++mc) { const int i = lane + 64 * mc; const bool in = i < n;
        const unsigned u = in ? val[i] : 0u; const unsigned short id = in ? idx[i] : (unsigned short)0;
        const bool gt = in && u > T, eq = in && u == T;
        const unsigned long long eqm = __ballot(eq);
        const bool keep = gt || (eq && (eqc + (int)__popcll(eqm & ltm)) < kk);
        const unsigned long long km = __ballot(keep);
        const int dst = outp + (int)__popcll(km & ltm);
        if (keep) { val[dst] = u; idx[dst] = id; }
        outp += (int)__popcll(km); eqc += (int)__popcll(eqm); }
    LDS_WAIT();
    return T;
}
__device__ __forceinline__ int compact_approx(LAS unsigned* val, LAS unsigned short* idx, LAS unsigned* hist, int n, unsigned& edge_u, unsigned umax, int lane, int need, bool dry) {
    const unsigned range = umax - edge_u;
    const int sh = max(0, 24 - (int)__builtin_clz(range | 1u));
    const int nst = (n + 255) >> 8;
    const unsigned long long ltm = (1ull << lane) - 1ull;
    *(LAS u32x4*)(hist + 4 * lane) = (u32x4){0u, 0u, 0u, 0u};
    LDS_WAIT();
#pragma nounroll
    for (int st = 0; st < nst; ++st) { const int i0 = 256 * st + lane; unsigned u[4];
#pragma unroll
        for (int c = 0; c < 4; ++c) u[c] = (i0 + 64 * c) < n ? val[i0 + 64 * c] : 0u;
#pragma unroll
        for (int c = 0; c < 4; ++c) if ((i0 + 64 * c) < n && u[c] > edge_u) __hip_atomic_fetch_add(&hist[min((u[c] - edge_u) >> sh, 255u)], 1u, __ATOMIC_RELAXED, __HIP_MEMORY_SCOPE_WAVEFRONT); }
    LDS_WAIT();
    int b, above; hist_find(hist, need, lane, b, above);
    const unsigned E = edge_u + ((unsigned)b << sh);
    if (dry) { edge_u = E - 1u; return n; }
    int outp = 0;
#pragma nounroll
    for (int st = 0; st < nst; ++st) { const int i0 = 256 * st + lane; unsigned u[4]; unsigned short id[4]; unsigned long long km[4];
#pragma unroll
        for (int c = 0; c < 4; ++c) { const bool in = (i0 + 64 * c) < n; u[c] = in ? val[i0 + 64 * c] : 0u; id[c] = in ? idx[i0 + 64 * c] : (unsigned short)0; }
#pragma unroll
        for (int c = 0; c < 4; ++c) km[c] = __builtin_amdgcn_ballot_w64((i0 + 64 * c) < n && u[c] >= E);
#pragma unroll
        for (int c = 0; c < 4; ++c) { const bool keep = (i0 + 64 * c) < n && u[c] >= E; const int dst = outp + (int)__popcll(km[c] & ltm);
            if (keep) { val[dst] = u[c]; idx[dst] = id[c]; }
            outp += (int)__popcll(km[c]); } }
    LDS_WAIT();
    edge_u = E - 1u;
    return outp;
}
__device__ __forceinline__ int select_final(LAS unsigned* val, LAS unsigned short* idx, LAS unsigned* hist, LAS unsigned* side, LAS unsigned short* list, int n, unsigned edge_u, unsigned umax, int lane) {
    if (n <= 256) { for (int i = lane; i < n; i += 64) list[i] = idx[i]; LDS_WAIT(); return n; }
    const unsigned range = umax - edge_u;
    const int sh = max(0, 24 - (int)__builtin_clz(range | 1u));
    const int nst = (n + 255) >> 8;
    const unsigned long long ltm = (1ull << lane) - 1ull;
    *(LAS u32x4*)(hist + 4 * lane) = (u32x4){0u, 0u, 0u, 0u};
    LDS_WAIT();
#pragma nounroll
    for (int st = 0; st < nst; ++st) { const int i0 = 256 * st + lane; unsigned u[4];
#pragma unroll
        for (int c = 0; c < 4; ++c) u[c] = (i0 + 64 * c) < n ? val[i0 + 64 * c] : 0u;
#pragma unroll
        for (int c = 0; c < 4; ++c) if ((i0 + 64 * c) < n) __hip_atomic_fetch_add(&hist[min((u[c] - edge_u) >> sh, 255u)], 1u, __ATOMIC_RELAXED, __HIP_MEMORY_SCOPE_WAVEFRONT); }
    LDS_WAIT();
    int b, above; hist_find(hist, 256, lane, b, above);
    const int cb = __builtin_amdgcn_readfirstlane((int)hist[b]);
    if (cb > 64) { (void)compact256(val, idx, hist, n, lane); for (int i = lane; i < 256; i += 64) list[i] = idx[i]; LDS_WAIT(); return 256; }
    const int kk = 256 - above;
    int outp = 0, sc = 0;
#pragma nounroll
    for (int st = 0; st < nst; ++st) { const int i0 = 256 * st + lane; unsigned u[4]; unsigned short id[4]; unsigned long long km[4], em[4];
#pragma unroll
        for (int c = 0; c < 4; ++c) { const bool in = (i0 + 64 * c) < n; u[c] = in ? val[i0 + 64 * c] : 0u; id[c] = in ? idx[i0 + 64 * c] : (unsigned short)0; }
#pragma unroll
        for (int c = 0; c < 4; ++c) { const bool in = (i0 + 64 * c) < n; const int bin = (int)min((u[c] - edge_u) >> sh, 255u); km[c] = __builtin_amdgcn_ballot_w64(in && bin > b); em[c] = __builtin_amdgcn_ballot_w64(in && bin == b); }
#pragma unroll
        for (int c = 0; c < 4; ++c) { const bool in = (i0 + 64 * c) < n; const int bin = (int)min((u[c] - edge_u) >> sh, 255u);
            if (in && bin > b) list[outp + (int)__popcll(km[c] & ltm)] = id[c];
            if (in && bin == b) { const int j = sc + (int)__popcll(em[c] & ltm); side[j] = u[c]; side[64 + j] = (unsigned)id[c]; }
            outp += (int)__popcll(km[c]); sc += (int)__popcll(em[c]); } }
    LDS_WAIT();
    bool keep = false; unsigned myid = 0u;
    if (lane < cb) { const unsigned u = side[lane]; myid = side[64 + lane]; int rank = 0;
        for (int j = 0; j < cb; ++j) { const unsigned uj = side[j]; rank += (uj > u || (uj == u && j < lane)) ? 1 : 0; }
        keep = rank < kk; }
    const unsigned long long km = __ballot(keep);
    if (keep) list[outp + (int)__popcll(km & ltm)] = (unsigned short)myid;
    LDS_WAIT();
    return 256;
}

__device__ __forceinline__ void mixa_dma(const Ptrs& P, LAS unsigned char* tb, size_t rowb, const LAS unsigned short* list, int nsel, int tile, int lane) {
    const int gr = lane >> 2, gp4 = lane & 3;
    const int ki = 16 * tile + gr; const int key = ki < nsel ? (int)list[ki] : 0; const char* src = (const char*)(P.KV + (rowb + key) * KVS) + gp4 * 16;
#pragma unroll
    for (int i = 0; i < 9; ++i) __builtin_amdgcn_global_load_lds((const unsigned*)(src + 64 * i), (LAS unsigned*)(tb + 1024 * i), 16, 0, 0);
}
__device__ __forceinline__ void mixa_step(const Ptrs& P, LAS unsigned char* tb, LAS unsigned char* tnext, size_t rowb, const LAS unsigned short* list, int nsel, int tile, int ntile, int lane,
                                          const bf16x8 (&qf)[8], const bf16x8 qr, float& m, float& lsum, f32x4 (&O)[16]) {
    const int fr = lane & 15, fq = lane >> 4;
    const bf16x8 zero8 = (bf16x8){0, 0, 0, 0, 0, 0, 0, 0};
    asm volatile("s_waitcnt vmcnt(0)" ::: "memory");
    mixa_dma(P, tnext, rowb, list, nsel, min(tile + 1, ntile - 1), lane);
    f32x4 zc0 = (f32x4){0.f, 0.f, 0.f, 0.f}, zc1 = (f32x4){0.f, 0.f, 0.f, 0.f}, zr = (f32x4){0.f, 0.f, 0.f, 0.f};
    const unsigned ta = (unsigned)(size_t)tb + (unsigned)(fr * 64 + 16 * fq), tra = (unsigned)(size_t)tb + (unsigned)(8192 + fr * 64 + 16 * (fq & 1));
    u32x4 kf0, kf1, kf2, kf3, kf4, kf5, kf6, kf7, kfr;
    asm volatile("ds_read_b128 %0, %9\n\tds_read_b128 %1, %9 offset:1024\n\tds_read_b128 %2, %9 offset:2048\n\tds_read_b128 %3, %9 offset:3072\n\tds_read_b128 %4, %9 offset:4096\n\t"
                 "ds_read_b128 %5, %9 offset:5120\n\tds_read_b128 %6, %9 offset:6144\n\tds_read_b128 %7, %9 offset:7168\n\tds_read_b128 %8, %10\n\ts_waitcnt lgkmcnt(0)"
                 : "=&v"(kf0), "=&v"(kf1), "=&v"(kf2), "=&v"(kf3), "=&v"(kf4), "=&v"(kf5), "=&v"(kf6), "=&v"(kf7), "=&v"(kfr) : "v"(ta), "v"(tra) : "memory");
    zc0 = __builtin_amdgcn_mfma_f32_16x16x32_bf16(__builtin_bit_cast(bf16x8, kf0), qf[0], zc0, 0, 0, 0);
    zc1 = __builtin_amdgcn_mfma_f32_16x16x32_bf16(__builtin_bit_cast(bf16x8, kf1), qf[1], zc1, 0, 0, 0);
    zc0 = __builtin_amdgcn_mfma_f32_16x16x32_bf16(__builtin_bit_cast(bf16x8, kf2), qf[2], zc0, 0, 0, 0);
    zc1 = __builtin_amdgcn_mfma_f32_16x16x32_bf16(__builtin_bit_cast(bf16x8, kf3), qf[3], zc1, 0, 0, 0);
    zc0 = __builtin_amdgcn_mfma_f32_16x16x32_bf16(__builtin_bit_cast(bf16x8, kf4), qf[4], zc0, 0, 0, 0);
    zc1 = __builtin_amdgcn_mfma_f32_16x16x32_bf16(__builtin_bit_cast(bf16x8, kf5), qf[5], zc1, 0, 0, 0);
    zc0 = __builtin_amdgcn_mfma_f32_16x16x32_bf16(__builtin_bit_cast(bf16x8, kf6), qf[6], zc0, 0, 0, 0);
    zc1 = __builtin_amdgcn_mfma_f32_16x16x32_bf16(__builtin_bit_cast(bf16x8, kf7), qf[7], zc1, 0, 0, 0);
    { bf16x8 a = __builtin_bit_cast(bf16x8, kfr); a = fq < 2 ? a : zero8; zr = __builtin_amdgcn_mfma_f32_16x16x32_bf16(a, qr, zr, 0, 0, 0); }
    const float zcv[4] = {zc0.x + zc1.x, zc0.y + zc1.y, zc0.z + zc1.z, zc0.w + zc1.w}, zrv[4] = {zr.x, zr.y, zr.z, zr.w};
    float sv[4];
#pragma unroll
    for (int jj = 0; jj < 4; ++jj) { const bool ok = (16 * tile + 4 * fq + jj) < nsel; sv[jj] = ok ? zcv[jj] + zrv[jj] : -INFINITY; }
    float tmax = fmaxf(fmaxf(sv[0], sv[1]), fmaxf(sv[2], sv[3]));
    { const auto r = __builtin_amdgcn_permlane16_swap(__float_as_uint(tmax), __float_as_uint(tmax), false, false); tmax = fmaxf(__uint_as_float(r[0]), __uint_as_float(r[1]));
      const auto q = __builtin_amdgcn_permlane32_swap(__float_as_uint(tmax), __float_as_uint(tmax), false, false); tmax = fmaxf(__uint_as_float(q[0]), __uint_as_float(q[1])); }
    if (__ballot(tmax > m + 16.f)) {
        const float mn = tmax > m + 16.f ? tmax : m;
        const float alpha = m == -INFINITY ? 0.f : __expf(m - mn);
        lsum *= alpha; m = mn;
#pragma unroll
        for (int c = 0; c < 16; ++c) O[c] = O[c] * alpha; }
    float p[4];
#pragma unroll
    for (int jj = 0; jj < 4; ++jj) p[jj] = __expf(sv[jj] - m);
    lsum += (p[0] + p[1]) + (p[2] + p[3]);
    u32x2 pw; pw.x = cvt_pk_bf16(p[0], p[1]); pw.y = cvt_pk_bf16(p[2], p[3]);
    const bf16x4 pb = __builtin_bit_cast(bf16x4, pw);
    const unsigned tr_base = (unsigned)(size_t)tb + (unsigned)((4 * fq + (fr >> 2)) * 64 + (fr & 3) * 8);
#pragma unroll
    for (int c8 = 0; c8 < 2; ++c8) {
        u32x2 t0, t1, t2, t3, t4, t5, t6, t7;
        asm volatile("s_waitcnt lgkmcnt(0)\n\tds_read_b64_tr_b16 %0, %8 offset:%9\n\tds_read_b64_tr_b16 %1, %8 offset:%10\n\tds_read_b64_tr_b16 %2, %8 offset:%11\n\tds_read_b64_tr_b16 %3, %8 offset:%12\n\t"
                     "ds_read_b64_tr_b16 %4, %8 offset:%13\n\tds_read_b64_tr_b16 %5, %8 offset:%14\n\tds_read_b64_tr_b16 %6, %8 offset:%15\n\tds_read_b64_tr_b16 %7, %8 offset:%16\n\ts_waitcnt lgkmcnt(0)"
                     : "=&v"(t0), "=&v"(t1), "=&v"(t2), "=&v"(t3), "=&v"(t4), "=&v"(t5), "=&v"(t6), "=&v"(t7)
                     : "v"(tr_base), "n"(4096 * c8), "n"(4096 * c8 + 32), "n"(4096 * c8 + 1024), "n"(4096 * c8 + 1056), "n"(4096 * c8 + 2048), "n"(4096 * c8 + 2080), "n"(4096 * c8 + 3072), "n"(4096 * c8 + 3104) : "memory");
        O[8 * c8 + 0] = __builtin_amdgcn_mfma_f32_16x16x16bf16_1k(__builtin_bit_cast(bf16x4, t0), pb, O[8 * c8 + 0], 0, 0, 0);
        O[8 * c8 + 1] = __builtin_amdgcn_mfma_f32_16x16x16bf16_1k(__builtin_bit_cast(bf16x4, t1), pb, O[8 * c8 + 1], 0, 0, 0);
        O[8 * c8 + 2] = __builtin_amdgcn_mfma_f32_16x16x16bf16_1k(__builtin_bit_cast(bf16x4, t2), pb, O[8 * c8 + 2], 0, 0, 0);
        O[8 * c8 + 3] = __builtin_amdgcn_mfma_f32_16x16x16bf16_1k(__builtin_bit_cast(bf16x4, t3), pb, O[8 * c8 + 3], 0, 0, 0);
        O[8 * c8 + 4] = __builtin_amdgcn_mfma_f32_16x16x16bf16_1k(__builtin_bit_cast(bf16x4, t4), pb, O[8 * c8 + 4], 0, 0, 0);
        O[8 * c8 + 5] = __builtin_amdgcn_mfma_f32_16x16x16bf16_1k(__builtin_bit_cast(bf16x4, t5), pb, O[8 * c8 + 5], 0, 0, 0);
        O[8 * c8 + 6] = __builtin_amdgcn_mfma_f32_16x16x16bf16_1k(__builtin_bit_cast(bf16x4, t6), pb, O[8 * c8 + 6], 0, 0, 0);
        O[8 * c8 + 7] = __builtin_amdgcn_mfma_f32_16x16x16bf16_1k(__builtin_bit_cast(bf16x4, t7), pb, O[8 * c8 + 7], 0, 0, 0);
    }
}
__device__ __forceinline__ void mixa_attend(const Ptrs& P, LAS unsigned char* wl, size_t row, size_t rowb, const LAS unsigned short* list, int nsel, int lane) {
    const int fr = lane & 15, fq = lane >> 4;
    const bf16x8 zero8 = (bf16x8){0, 0, 0, 0, 0, 0, 0, 0};
    const int ntile = (nsel + 15) >> 4;
    mixa_dma(P, wl + MA_TILE, rowb, list, nsel, 0, lane);
    bf16x8 qf[8], qr;
#pragma unroll
    for (int s = 0; s < 8; ++s) { u32x2 w8 = (u32x2){0u, 0u}; if (fr < 8) w8 = *(const u32x2*)((const unsigned char*)P.QL + row * 2048 + fr * 256 + 32 * s + 8 * fq);
        const f32x4 lo = up4_fp8(w8.x) * 0.125f, hi = up4_fp8(w8.y) * 0.125f; u32x4 pk; pk.x = cvt_pk_bf16(lo.x, lo.y); pk.y = cvt_pk_bf16(lo.z, lo.w); pk.z = cvt_pk_bf16(hi.x, hi.y); pk.w = cvt_pk_bf16(hi.z, hi.w);
        qf[s] = __builtin_bit_cast(bf16x8, pk); }
    qr = (fr < 8 && fq < 2) ? *(const bf16x8*)(P.AQ + row * 512 + fr * 64 + 8 * fq) : zero8;
    float m = -INFINITY, lsum = 0.f;
    f32x4 O[16];
#pragma unroll
    for (int c = 0; c < 16; ++c) O[c] = (f32x4){0.f, 0.f, 0.f, 0.f};
#pragma nounroll
    for (int tile = 0; tile < ntile; tile += 2) {
        mixa_step(P, wl + MA_TILE, wl + MA_TILEB, rowb, list, nsel, tile, ntile, lane, qf, qr, m, lsum, O);
        if (tile + 1 < ntile) mixa_step(P, wl + MA_TILEB, wl + MA_TILE, rowb, list, nsel, tile + 1, ntile, lane, qf, qr, m, lsum, O);
    }
    asm volatile("s_waitcnt vmcnt(0)" ::: "memory");
    float lt = lsum; lt += __shfl_xor(lt, 16); lt += __shfl_xor(lt, 32);
    const float inv = 1.f / lt;
    if (fr < 8) {
#pragma unroll
        for (int c = 0; c < 16; ++c) { const f32x4 v = O[c] * (inv * 8.f); *(LAS unsigned*)(wl + MA_TILE + fr * 256 + 16 * c + 4 * fq) = pk4_fp8(v.x, v.y, v.z, v.w); } }
    LDS_WAIT();
#pragma unroll
    for (int i = 0; i < 2; ++i) { const int h = 4 * i + (lane >> 4); const u32x4 o = *(const LAS u32x4*)(wl + MA_TILE + h * 256 + (lane & 15) * 16); *(u32x4*)((unsigned char*)P.OL + row * 2048 + h * 256 + (lane & 15) * 16) = o; }
    LDS_WAIT();
}

#define IDX_GROUP(ca, cb, cc, cd, s01, s23) do { \
        const f32x4 za = __builtin_amdgcn_mfma_f32_16x16x32_bf16(xq, ca, z4, 0, 0, 0), zb = __builtin_amdgcn_mfma_f32_16x16x32_bf16(xq, cb, z4, 0, 0, 0); \
        const f32x4 zc = __builtin_amdgcn_mfma_f32_16x16x32_bf16(xq, cc, z4, 0, 0, 0), zd = __builtin_amdgcn_mfma_f32_16x16x32_bf16(xq, cd, z4, 0, 0, 0); \
        const f32x4 la = __builtin_amdgcn_mfma_f32_16x16x32_bf16(xl, ca, z4, 0, 0, 0), lb = __builtin_amdgcn_mfma_f32_16x16x32_bf16(xl, cb, z4, 0, 0, 0); \
        const f32x4 lc = __builtin_amdgcn_mfma_f32_16x16x32_bf16(xl, cc, z4, 0, 0, 0), ld = __builtin_amdgcn_mfma_f32_16x16x32_bf16(xl, cd, z4, 0, 0, 0); \
        const float pa = fmaf(hw.w, fabsf(za.w), fmaf(hw.z, fabsf(za.z), fmaf(hw.y, fabsf(za.y), fmaf(hw.x, fabsf(za.x), la.x)))); \
        const float pb = fmaf(hw.w, fabsf(zb.w), fmaf(hw.z, fabsf(zb.z), fmaf(hw.y, fabsf(zb.y), fmaf(hw.x, fabsf(zb.x), lb.x)))); \
        const float pc = fmaf(hw.w, fabsf(zc.w), fmaf(hw.z, fabsf(zc.z), fmaf(hw.y, fabsf(zc.y), fmaf(hw.x, fabsf(zc.x), lc.x)))); \
        const float pd = fmaf(hw.w, fabsf(zd.w), fmaf(hw.z, fabsf(zd.z), fmaf(hw.y, fabsf(zd.y), fmaf(hw.x, fabsf(zd.x), ld.x)))); \
        const auto r01 = __builtin_amdgcn_permlane16_swap(__float_as_uint(pa), __float_as_uint(pb), false, false); \
        const auto r23 = __builtin_amdgcn_permlane16_swap(__float_as_uint(pc), __float_as_uint(pd), false, false); \
        s01 = (__uint_as_float(r01[0]) + __uint_as_float(r01[1])) + 0.f; s23 = (__uint_as_float(r23[0]) + __uint_as_float(r23[1])) + 0.f; } while (0)
__device__ __forceinline__ void mixa_pair(const Ptrs& P, LAS unsigned char* wl, int b, int pp, int lane) {
    const int fr = lane & 15, fq = lane >> 4, half = fq >> 1; const size_t rowb = (size_t)b * SEQ; const int tA = 2 * pp;
    LAS unsigned* aval = (LAS unsigned*)(wl + MA_AVAL); LAS unsigned short* aidx = (LAS unsigned short*)(wl + MA_AIDX);
    LAS unsigned* bval = (LAS unsigned*)(wl + MA_BVAL); LAS unsigned short* bidx = (LAS unsigned short*)(wl + MA_BIDX); LAS unsigned* hist = (LAS unsigned*)(wl + MA_HIST);
    LAS unsigned* side = (LAS unsigned*)(wl + MA_SIDE);
    const bf16x8 xq = *(const bf16x8*)(P.IQ + (rowb + tA + (fr >> 3)) * 256 + (fr & 7) * 32 + 8 * fq);
    const f32x4 wv = *(const f32x4*)(P.IW + (rowb + tA + half) * 8 + 4 * (fq & 1));
    const f32x4 hw = wv * 0.5f;
    bf16x8 xl;
    { const size_t qrow = rowb + tA + (fr >> 3); const f32x4 w0 = *(const f32x4*)(P.IW + qrow * 8), w1 = *(const f32x4*)(P.IW + qrow * 8 + 4);
      const float wh[8] = {w0.x, w0.y, w0.z, w0.w, w1.x, w1.y, w1.z, w1.w}; float lv[8] = {0.f, 0.f, 0.f, 0.f, 0.f, 0.f, 0.f, 0.f};
#pragma unroll
      for (int h = 0; h < 8; ++h) { const u32x4 q4 = *(const u32x4*)(P.IQ + qrow * 256 + h * 32 + 8 * fq); const unsigned qq[4] = {q4.x, q4.y, q4.z, q4.w};
#pragma unroll
          for (int e = 0; e < 4; ++e) { lv[2 * e] = fmaf(wh[h], __uint_as_float(qq[e] << 16), lv[2 * e]); lv[2 * e + 1] = fmaf(wh[h], __uint_as_float(qq[e] & 0xffff0000u), lv[2 * e + 1]); } }
      u32x4 pk; pk.x = cvt_pk_bf16(lv[0] * 0.25f, lv[1] * 0.25f); pk.y = cvt_pk_bf16(lv[2] * 0.25f, lv[3] * 0.25f); pk.z = cvt_pk_bf16(lv[4] * 0.25f, lv[5] * 0.25f); pk.w = cvt_pk_bf16(lv[6] * 0.25f, lv[7] * 0.25f);
      xl = __builtin_bit_cast(bf16x8, pk); }
    const int tq = tA + half;
    unsigned edgeA, edgeB; float tauA, tauB; int cntA, cntB;
    unsigned umx;
    const int ntile = ((tA + 1) >> 4) + 1, niter = (ntile + 7) >> 3;
    const bf16* ikp = P.IK + (rowb + fr) * 32 + 8 * fq;
    const unsigned lt32 = (1u << (lane & 31)) - 1u;
    const f32x4 z4 = (f32x4){0.f, 0.f, 0.f, 0.f};
    const int jneed = (256 * 700) / (tA + 1) + 1;
#pragma nounroll
    for (int pass = 0; pass < 2; ++pass) {
    const bool spec = pass == 0 && niter > 9;
    edgeA = f2u(-INFINITY); edgeB = edgeA; tauA = -INFINITY; tauB = -INFINITY; cntA = 0; cntB = 0; umx = f2u(-INFINITY);
    bf16x8 y0 = *(const bf16x8*)ikp, y1 = *(const bf16x8*)(ikp + 512), y2 = *(const bf16x8*)(ikp + 1024), y3 = *(const bf16x8*)(ikp + 1536);
    bf16x8 y4 = *(const bf16x8*)(ikp + 2048), y5 = *(const bf16x8*)(ikp + 2560), y6 = *(const bf16x8*)(ikp + 3072), y7 = *(const bf16x8*)(ikp + 3584);
#pragma nounroll
    for (int it = 0; it < niter; ++it) {
        const bf16* np = ikp + (size_t)min(it + 1, niter - 1) * 4096;
        float s0, s1, s2, s3;
        IDX_GROUP(y0, y1, y2, y3, s0, s1);
        y0 = *(const bf16x8*)np; y1 = *(const bf16x8*)(np + 512); y2 = *(const bf16x8*)(np + 1024); y3 = *(const bf16x8*)(np + 1536);
        IDX_GROUP(y4, y5, y6, y7, s2, s3);
        y4 = *(const bf16x8*)(np + 2048); y5 = *(const bf16x8*)(np + 2560); y6 = *(const bf16x8*)(np + 3072); y7 = *(const bf16x8*)(np + 3584);
        const int k0 = 128 * it + 16 * (fq & 1) + fr;
        const float tau = half ? tauB : tauA;
        if (it == niter - 1) { s0 = k0 <= tq ? s0 : -INFINITY; s1 = k0 + 32 <= tq ? s1 : -INFINITY; s2 = k0 + 64 <= tq ? s2 : -INFINITY; s3 = k0 + 96 <= tq ? s3 : -INFINITY; }
        const bool d0 = s0 > tau, d1 = s1 > tau, d2 = s2 > tau, d3 = s3 > tau;
        const unsigned long long m0 = __builtin_amdgcn_ballot_w64(s0 > tau), m1 = __builtin_amdgcn_ballot_w64(s1 > tau);
        const unsigned long long m2 = __builtin_amdgcn_ballot_w64(s2 > tau), m3 = __builtin_amdgcn_ballot_w64(s3 > tau);
        if ((m0 | m1) | (m2 | m3)) {
            const unsigned h0 = half ? (unsigned)(m0 >> 32) : (unsigned)m0, h1 = half ? (unsigned)(m1 >> 32) : (unsigned)m1, h2 = half ? (unsigned)(m2 >> 32) : (unsigned)m2, h3 = half ? (unsigned)(m3 >> 32) : (unsigned)m3;
            const int base = half ? cntB : cntA;
            const int p0 = base + __popc(h0 & lt32), p1 = base + __popc(h0) + __popc(h1 & lt32), p2 = base + __popc(h0) + __popc(h1) + __popc(h2 & lt32), p3 = base + __popc(h0) + __popc(h1) + __popc(h2) + __popc(h3 & lt32);
            LAS unsigned* v = half ? bval : aval; LAS unsigned short* ix = half ? bidx : aidx;
            if (d0) { const unsigned u_ = f2u(s0); v[p0] = u_; ix[p0] = (unsigned short)k0; umx = umx > u_ ? umx : u_; }
            if (d1) { const unsigned u_ = f2u(s1); v[p1] = u_; ix[p1] = (unsigned short)(k0 + 32); umx = umx > u_ ? umx : u_; }
            if (d2) { const unsigned u_ = f2u(s2); v[p2] = u_; ix[p2] = (unsigned short)(k0 + 64); umx = umx > u_ ? umx : u_; }
            if (d3) { const unsigned u_ = f2u(s3); v[p3] = u_; ix[p3] = (unsigned short)(k0 + 96); umx = umx > u_ ? umx : u_; }
            cntA += (__popc((unsigned)m0) + __popc((unsigned)m1)) + (__popc((unsigned)m2) + __popc((unsigned)m3));
            cntB += (__popc((unsigned)(m0 >> 32)) + __popc((unsigned)(m1 >> 32))) + (__popc((unsigned)(m2 >> 32)) + __popc((unsigned)(m3 >> 32)));
            const bool sp = spec && it == 1;
            if (cntA > CAP - 128 || cntB > CAP - 128 || sp) {
#pragma nounroll
                for (int qq = 0; qq < 2; ++qq) { const int cq = qq ? cntB : cntA;
                    if (cq > CAP - 128 || sp) { LDS_WAIT(); const unsigned umax = wave_umax((half == qq) ? umx : f2u(-INFINITY)); unsigned eq = qq ? edgeB : edgeA;
                        LAS unsigned* cv = qq ? bval : aval; LAS unsigned short* ci = qq ? bidx : aidx;
                        const int need = sp ? jneed : 256; int n2 = cq;
#pragma nounroll
                        for (int r = 0; r < (sp ? 2 : 1); ++r) n2 = compact_approx(cv, ci, hist, n2, eq, umax, lane, need, sp && r == 0);
                        if (n2 > CAP - 256) { eq = compact256(cv, ci, hist, n2, lane); n2 = 256; }
                        if (qq) { cntB = n2; edgeB = eq; tauB = u2f(eq); } else { cntA = n2; edgeA = eq; tauA = u2f(eq); } } } }
        }
    }
    if (!spec || (cntA >= 256 && cntB >= 256)) break;
    }
    LDS_WAIT();
    LAS unsigned short* listA = (LAS unsigned short*)(wl + MA_LIST); LAS unsigned short* listB = listA + 256;
    const unsigned umaxA = wave_umax(half ? f2u(-INFINITY) : umx), umaxB = wave_umax(half ? umx : f2u(-INFINITY));
    int nA = 0, nB = 0;
#pragma nounroll
    for (int qq = 0; qq < 2; ++qq) { const int n = select_final(qq ? bval : aval, qq ? bidx : aidx, hist, side, qq ? listB : listA, qq ? cntB : cntA, qq ? edgeB : edgeA, qq ? umaxB : umaxA, lane); if (qq) nB = n; else nA = n; }
#pragma nounroll
    for (int qq = 0; qq < 2; ++qq) mixa_attend(P, wl, rowb + tA + qq, rowb, qq ? listB : listA, qq ? nB : nA, lane);
}

__device__ __forceinline__ void mixer_phase(const Ptrs& P, LAS unsigned char* lds, int gw, int NGW, int wave, int lane) {
    LAS unsigned char* wl = lds + wave * MIX_WAVE_LDS;
    if (NGW == 2048) {
        const int b = gw >> 9, r = (gw >> 3) & 63;
        const int rot = ((wave ^ (wave >> 2)) & 1) ? 4 : 0;
#pragma nounroll
        for (int k0 = 0; k0 < 8; ++k0) { const int k = (k0 + rot) & 7; const int g = ((k & 1) ? 63 - r : r) + 64 * k; mixa_pair(P, wl, b, 8 * g + wave, lane); }
    } else {
#pragma nounroll
        for (int pg = gw; pg < NBATCH * 4096; pg += NGW) mixa_pair(P, wl, pg >> 12, pg & 4095, lane);
    }
    { int qb = (gw * (2 * NBATCH) / NGW) & (2 * NBATCH - 1), dry = 0;
#pragma nounroll
      for (;;) { unsigned q = 0u; if (lane == 0) q = __hip_atomic_fetch_add(P.ctl + CW_BQ + 64 * qb, 1u, __ATOMIC_RELAXED, __HIP_MEMORY_SCOPE_AGENT);
          const int it = __builtin_amdgcn_readfirstlane((int)q);
          if (it >= 32 * 16 * 2) { if (++dry == 2 * NBATCH) break; qb = (qb + 1) & (2 * NBATCH - 1); continue; }
          dry = 0;
          const int c = it & 15, j = 2 * (qb & 1) + ((it >> 4) & 1), tb = 31 - (it >> 5); mixb_item(P, wl, qb >> 1, tb, c, j, lane); } }
    if (NGW == 2048) {
        __syncthreads();
        const int b = gw >> 9, r = (gw >> 3) & 63;
        headgemm_wave<256, 64, false, true>((const bf16*)((const unsigned char*)P.OL + wave * 256), 2048, P.WV + (size_t)wave * 64 * 256, P.AB + wave * 64, 768, [=](int k) { return b * 512 + ((k & 1) ? 63 - r : r) + 64 * k; }, 8, lane);
    }
}

constexpr int NPHASE = 11;
__global__ void __launch_bounds__(NWAVES * 64, 2) fwd(Args args) {
    extern __shared__ __attribute__((aligned(16))) unsigned char lds_raw[];
    LAS unsigned char* lds = (LAS unsigned char*)lds_raw;
    const int tid = threadIdx.x, lane = tid & 63, wave = __builtin_amdgcn_readfirstlane(tid >> 6);
    const int G = gridDim.x; const int bx = blockIdx.x; const int vcu = (G % 8 == 0) ? (bx % 8) * (G / 8) + bx / 8 : bx;
    const int gw = vcu * NWAVES + wave, NGW = G * NWAVES;
    unsigned char* ws = args.ws;
    Ptrs P;
    P.x = (const float*)args.in[0]; P.positions = (const int*)args.in[1]; P.w_in = (const float*)args.in[2]; P.b_gate = (const float*)args.in[3]; P.g_kv = (const float*)args.in[4];
    P.w_uk = (const float*)args.in[5]; P.w_uv = (const float*)args.in[6]; P.w_ba = (const float*)args.in[7]; P.w_bb = (const float*)args.in[8]; P.w_o = (const float*)args.in[9];
    P.ln1_g = (const float*)args.in[10]; P.ln1_b = (const float*)args.in[11]; P.w_router = (const float*)args.in[12]; P.router_bias = (const float*)args.in[13];
    P.w1_e = (const float*)args.in[14]; P.w3_e = (const float*)args.in[15]; P.w2_e = (const float*)args.in[16]; P.ws1 = (const float*)args.in[17]; P.ws3 = (const float*)args.in[18]; P.ws2 = (const float*)args.in[19];
    P.ln2_g = (const float*)args.in[20]; P.ln2_b = (const float*)args.in[21];
    P.out = args.out; P.ws = ws; P.ctl = (gu32*)(ws + WS_CTL);
    P.XB = (bf16*)(ws + WS_XB); P.WIN = (bf16*)(ws + WS_WIN); P.WAB = (bf16*)(ws + WS_WAB); P.X8 = ws + WS_X8; P.WG8 = ws + WS_WG8; P.WQ = (bf16*)(ws + WS_WQ); P.WV = (bf16*)(ws + WS_WV); P.WO = (bf16*)(ws + WS_WO); P.AB = (bf16*)((unsigned char*)args.out + 64 * MiB);

    P.QL = (bf16*)(ws + WS_QL); P.KV = (bf16*)(ws + WS_KV); P.IQ = (bf16*)(ws + WS_IQ); P.AQ = (bf16*)(ws + WS_AQ); P.IK = (bf16*)(ws + WS_IK); P.IW = (float*)(ws + WS_IW);
    P.BQ = (bf16*)(ws + WS_BQ); P.BK = (bf16*)(ws + WS_BK); P.BV = (bf16*)(ws + WS_BV); P.OL = (bf16*)(ws + WS_OL);
    P.G = (unsigned char*)args.out; P.MP = (bf16*)(ws + WS_MP); P.HBF = (bf16*)args.out;
    P.W13 = (bf16*)(ws + WS_W13); P.W2 = (bf16*)(ws + WS_W2);
    P.HB = (bf16*)(ws + WS_HB); P.Y = (bf16*)(ws + WS_Y);
    P.R16 = (f32x2*)(ws + WS_R16); P.R8 = (f32x2*)(ws + WS_R8); P.REC = (unsigned*)(ws + WS_REC); P.LIST = (int*)(ws + WS_LIST); P.WLIST = (float*)(ws + WS_WLIST);

    if (tid < 16) ((LAS unsigned*)(lds + LDS_BARW))[tid] = 0u;
    __syncthreads();
    XcdBarrier bar = xcd_barrier_post((unsigned*)(P.ctl + CW_BAR), (volatile LAS unsigned*)(lds + LDS_BARW));
    MoeTab MT; MT.pre = (LAS int*)(lds + 135168); MT.cnt = (LAS int*)(lds + 135168 + 512);

    const int lo = args.ph_lo, hi = args.ph_hi;
#ifndef ONLYPH
#define ONLYPH -1
#endif
#define IN(k) ((ONLYPH < 0 || ONLYPH == (k)) && lo <= (k) && (k) < hi)
#define SEAM(k) do { if (IN(k) && IN((k) + 1)) xcd_barrier(bar); } while (0)

    if (IN(0)) { p0_phase(P, lds, gw, NGW, wave, lane); } SEAM(0);
    if (IN(1)) { gp::DenseOrder S; S.init(P.XB, P.WIN + (size_t)768 * DM, DM * 2, DM * 2, NTOK, 2 * 256, G, bx); EpiP1 E; E.P = P;
        gp::gemm_phase<EpiP1, gp::DenseOrder, false>(lds, DM, DM * 2, DM * 2, S, E); }
    if (IN(1)) {
        gp::DenseOrder S; S.init(P.X8, P.WG8, DM, DM, NTOK, 5120, G, bx, 128); EpiG E; E.b_gate = P.b_gate; E.G = P.G; E.BQ = P.BQ; E.BK = P.BK; E.BV = P.BV; E.KV = P.KV; E.AQ = P.AQ; E.R16 = P.R16;
        gp::gemm_phase<EpiG, gp::DenseOrder, false, true, 1>(lds, DM / 2, DM, DM, S, E); } SEAM(1);
    if (IN(2)) {
        headgemm_wave<64, 256, true>(P.AQ + wave * 64, 512, P.WQ + (size_t)wave * 256 * 64, (bf16*)((unsigned char*)P.QL + wave * 256), 2048,
            [=](int i) { return vcu + i * G; }, (NTOK / 16 - vcu + G - 1) / G, lane);
#pragma nounroll
        for (int r0 = gw * 4; r0 < NTOK; r0 += NGW * 4) { u32x2 v[4]; f32x4 q4[4];
#pragma unroll
            for (int i = 0; i < 4; ++i) { bf16* kr = P.KV + (size_t)(r0 + i) * KVS; v[i] = *((const u32x2*)kr + lane); q4[i] = *(const f32x4*)(kr + 272) + *(const f32x4*)(kr + 280); }
#pragma unroll
            for (int i = 0; i < 4; ++i) { const float rs = __builtin_amdgcn_rsqf(((q4[i].x + q4[i].y) + (q4[i].z + q4[i].w)) * (1.f / 256.f) + RMS_EPS);
                u32x2 o; o.x = cvt_pk_bf16(__uint_as_float(v[i].x << 16) * rs, __uint_as_float(v[i].x & 0xffff0000u) * rs); o.y = cvt_pk_bf16(__uint_as_float(v[i].y << 16) * rs, __uint_as_float(v[i].y & 0xffff0000u) * rs);
                *((u32x2*)(P.KV + (size_t)(r0 + i) * KVS) + lane) = o; } } } SEAM(2);
    if (IN(3)) { mixer_phase(P, lds, gw, NGW, wave, lane); } SEAM(3);
    if (NGW != 2048) {
        if (IN(4)) {
            headgemm_wave<256, 64, false, true>((const bf16*)((const unsigned char*)P.OL + wave * 256), 2048, P.WV + (size_t)wave * 64 * 256, P.AB + wave * 64, 768, [=](int i) { return vcu + i * G; }, (NTOK / 16 - vcu + G - 1) / G, lane); } SEAM(4); }
    if (IN(5)) { gp::DenseOrder S; S.init(P.AB, P.WAB, 768 * 2, 768 * 2, NTOK, DM, G, bx); EpiUV E; E.G = P.G; E.MP = P.MP;
        gp::gemm_phase<EpiUV, gp::DenseOrder, false>(lds, 768, 768 * 2, 768 * 2, S, E); } SEAM(5);
    if (IN(6)) { gp::DenseOrder S; S.init(P.MP, P.WO, DM * 2, DM * 2, NTOK, DM, G, bx); EpiO E; E.x = P.x; E.PRE = P.out;
        gp::gemm_phase<EpiO, gp::DenseOrder, false>(lds, DM, DM * 2, DM * 2, S, E); } SEAM(6);
    if (IN(7)) { ln1_router_phase(P, lds, vcu, G, gw, NGW, wave, lane); } SEAM(7);
    if (IN(8)) { moe_table(P, MT); MoeOrder1 S; S.H8 = (const unsigned char*)P.out + 2 * DM; S.W13 = (const unsigned char*)P.W13; S.LIST = P.LIST; S.T = MT; S.G = G; S.c = bx; EpiM1 E; E.HB = P.HB; E.WLIST = P.WLIST;
        gp::gemm_phase<EpiM1, MoeOrder1, true, true, 1>(lds, DM / 2, DM * 4, DM, S, E);
        expert_weights_w2(P, lds, wave, lane); } SEAM(8);
    if (IN(9)) { moe_table(P, MT);
        MoeOrder2 S; S.HB = P.HB; S.W2 = P.W2; S.T = MT; S.G = G; S.c = bx; S.e_lo = 0; S.e_hi = 65; EpiM2R E; E.Y = (unsigned char*)P.Y; E.WLIST = P.WLIST; E.lds = lds;
        gp::gemm_phase<EpiM2R, MoeOrder2, false>(lds, DEXP, DEXP * 2, DEXP * 2, S, E); } SEAM(9);
    if (IN(10)) { moe_table(P, MT); combine_phase<true>(P, MT, 0, 64, gw, NGW, lane); }
#undef IN
#undef SEAM
}

#ifndef MK_N_LAUNCHES
#define MK_N_LAUNCHES 1
#endif
extern "C" void kernel_launch(void* const* d_in, const int* in_sizes, int n_in, void* d_out, int out_size, void* d_ws, size_t ws_size, hipStream_t stream) {
    static int grid = 0;
    if (grid == 0) {
        if (n_in != 22 || out_size != NTOK * DM || ws_size < WS_END) { fprintf(stderr, "kernel_launch: unexpected problem (n_in %d out %d ws %zu)\n", n_in, out_size, ws_size); grid = -1; return; }
        int dev = 0, cus = 0, per_cu = 0;
        if (hipGetDevice(&dev) != hipSuccess || hipDeviceGetAttribute(&cus, hipDeviceAttributeMultiprocessorCount, dev) != hipSuccess) { grid = -1; return; }
        if (hipFuncSetAttribute((const void*)fwd, hipFuncAttributeMaxDynamicSharedMemorySize, LDS_BYTES) != hipSuccess) { fprintf(stderr, "kernel_launch: hipFuncSetAttribute failed\n"); grid = -1; return; }
        if (hipOccupancyMaxActiveBlocksPerMultiprocessor(&per_cu, (const void*)fwd, NWAVES * 64, LDS_BYTES) != hipSuccess || per_cu < 1) fprintf(stderr, "kernel_launch: occupancy query reports %d\n", per_cu);
        (void)hipGetLastError();
        grid = cus;
    }
    if (grid < 0) return;
    (void)hipMemsetAsync((char*)d_ws + WS_CTL, 0, CTL_ZERO_BYTES, stream);
    Args a{};
    for (int i = 0; i < 22; ++i) a.in[i] = d_in[i];
    a.out = (float*)d_out; a.ws = (unsigned char*)d_ws;
    if (MK_N_LAUNCHES == 1) { a.ph_lo = 0; a.ph_hi = NPHASE; hipLaunchKernelGGL(fwd, dim3(grid), dim3(NWAVES * 64), LDS_BYTES, stream, a); }
    else for (int p = 0; p < NPHASE; ++p) { a.ph_lo = p; a.ph_hi = p + 1; hipLaunchKernelGGL(fwd, dim3(grid), dim3(NWAVES * 64), LDS_BYTES, stream, a); }
}
```
